# Optimizing an MI355X kernel written in HIP

```python
import math, functools
import jax, jax.numpy as jnp
from jax import lax
import numpy as np

D_MODEL = 1024
BATCH = 2
SEQ = 8192
DEPTH = 1
DEC_BATCH = 128
DEC_SEQ = 4
PAST_LEN = 2048
PAGE_SIZE = 128

MIX_A = D_MODEL // 2
MIX_H = D_MODEL - MIX_A
A_HEAD_DIM = 64
A_HEADS = MIX_A // (2 * A_HEAD_DIM)
ROT_DIM = A_HEAD_DIM // 4
ROPE_THETA = 500000.0
H_EXPAND = 128
H_HEADS = MIX_H // H_EXPAND
D_FF = -(-8 * D_MODEL // (3 * 256)) * 256
N_IN = 3 * MIX_A + 4 * MIX_H
SPLITS = [MIX_A, 2 * MIX_A, 3 * MIX_A, 3 * MIX_A + MIX_H, 3 * MIX_A + 2 * MIX_H, 3 * MIX_A + 3 * MIX_H]
QBLK = 128
CHUNK = 64
EPS = 1e-6
SUBLN_EPS = 1e-5

kernel_name = "hymba_style_diffattn_hgrn2_step"


def rmsnorm(x, w, eps=EPS):
    xf = x.astype(jnp.float32)
    y = xf * lax.rsqrt(jnp.mean(xf * xf, axis=-1, keepdims=True) + eps)
    return (y * w.astype(jnp.float32)).astype(x.dtype)


def rope_partial(x, pos):
    half = ROT_DIM // 2
    inv_freq = 1.0 / (ROPE_THETA ** (jnp.arange(half, dtype=jnp.float32) * 2.0 / ROT_DIM))
    ang = pos.astype(jnp.float32)[:, None] * inv_freq[None, :]
    cos = jnp.cos(ang)[None, :, None, None, :]
    sin = jnp.sin(ang)[None, :, None, None, :]
    x1 = x[..., :half].astype(jnp.float32)
    x2 = x[..., half:ROT_DIM].astype(jnp.float32)
    rot = jnp.concatenate([x1 * cos - x2 * sin, x2 * cos + x1 * sin], axis=-1).astype(x.dtype)
    return jnp.concatenate([rot, x[..., ROT_DIM:]], axis=-1)


def diff_attn_prompt(q, k, v, lam):
    B, L = q.shape[0], q.shape[1]
    n_blk = L // QBLK
    scale = A_HEAD_DIM ** -0.5
    kpos = jnp.arange(L)

    def blk(i):
        qb = lax.dynamic_slice_in_dim(q, i * QBLK, QBLK, axis=1)
        s = jnp.einsum("bqhcd,bkhcd->bhcqk", qb, k).astype(jnp.float32) * scale
        qpos = i * QBLK + jnp.arange(QBLK)
        s = jnp.where(kpos[None, :] <= qpos[:, None], s, -jnp.inf)
        p = jax.nn.softmax(s, axis=-1)
        pd = p[:, :, 0] - lam * p[:, :, 1]
        return jnp.einsum("bhqk,bkhe->bqhe", pd.astype(v.dtype), v)

    o = lax.map(blk, jnp.arange(n_blk))
    return jnp.moveaxis(o, 0, 1).reshape(B, L, A_HEADS, 2 * A_HEAD_DIM)


def diff_attn_sample(q, k, v, lam, k_past, v_past):
    T = q.shape[1]
    P = k_past.shape[1]
    scale = A_HEAD_DIM ** -0.5
    s_past = jnp.einsum("bqhcd,bkhcd->bhcqk", q, k_past).astype(jnp.float32) * scale
    s_new = jnp.einsum("bqhcd,bkhcd->bhcqk", q, k).astype(jnp.float32) * scale
    s_new = jnp.where(jnp.tril(jnp.ones((T, T), bool)), s_new, -jnp.inf)
    p = jax.nn.softmax(jnp.concatenate([s_past, s_new], axis=-1), axis=-1)
    pd = (p[:, :, 0] - lam * p[:, :, 1]).astype(v.dtype)
    return (jnp.einsum("bhqk,bkhe->bqhe", pd[..., :P], v_past)
            + jnp.einsum("bhqk,bkhe->bqhe", pd[..., P:], v))


def gla_chunk_scan(q, k, v, logf, s0):
    B, L, H, DK = q.shape
    DV = v.shape[-1]
    C = math.gcd(L, CHUNK)
    n = L // C
    tri = jnp.tril(jnp.ones((C, C), bool))

    def to_chunks(t):
        return jnp.moveaxis(t.reshape(B, n, C, H, t.shape[-1]), 1, 0)

    def step(S, inp):
        qc, kc, vc, gc = inp
        b = jnp.cumsum(gc, axis=1)
        o_inter = jnp.einsum("bthk,bhkv->bthv", qc * jnp.exp(b), S)
        diff = jnp.where(tri[None, :, :, None, None], b[:, :, None] - b[:, None, :], -jnp.inf)
        A = jnp.einsum("bthk,btshk->btsh", qc, jnp.exp(diff) * kc[:, None])
        o_intra = jnp.einsum("btsh,bshv->bthv", A, vc)
        b_last = b[:, -1]
        S = S * jnp.exp(b_last)[..., None] + jnp.einsum(
            "bshk,bshv->bhkv", kc * jnp.exp(b_last[:, None] - b), vc)
        return S, o_inter + o_intra

    S, o = lax.scan(step, s0, (to_chunks(q), to_chunks(k), to_chunks(v), to_chunks(logf)))
    return jnp.moveaxis(o, 0, 1).reshape(B, L, H, DV), S


def trunk_layer(x, pos, s0, attend, attn_norm, w_in, w_out, subln_w, lam, lam_init, lb,
                hgrn_norm, ffn_norm, w_gate, w_up, w_down):
    B, L, _ = x.shape
    h = rmsnorm(x, attn_norm)
    z = h @ w_in
    qa, ka, va, qh, fh, ih, gh = jnp.split(z, SPLITS, axis=-1)
    qa = rope_partial(qa.reshape(B, L, A_HEADS, 2, A_HEAD_DIM), pos)
    ka = rope_partial(ka.reshape(B, L, A_HEADS, 2, A_HEAD_DIM), pos)
    va = va.reshape(B, L, A_HEADS, 2 * A_HEAD_DIM)
    oa = attend(qa, ka, va, lam)
    oa = (rmsnorm(oa, subln_w, SUBLN_EPS).astype(jnp.float32) * (1.0 - lam_init)).reshape(B, L, MIX_A)
    f = lb + (1.0 - lb) * jax.nn.sigmoid(fh.astype(jnp.float32))
    heads = lambda t: t.reshape(B, L, H_HEADS, H_EXPAND)
    oh, s_new = gla_chunk_scan(heads(jax.nn.silu(qh.astype(jnp.float32))), heads(1.0 - f),
                               heads(ih.astype(jnp.float32)), heads(jnp.log(f)), s0)
    oh = rmsnorm(oh.reshape(B, L, MIX_H), hgrn_norm) * jax.nn.silu(gh.astype(jnp.float32))
    mix = jnp.concatenate([oa.astype(x.dtype), oh.astype(x.dtype)], axis=-1)
    x = x + mix @ w_out
    h = rmsnorm(x, ffn_norm)
    x = x + (jax.nn.silu(h @ w_gate) * (h @ w_up)) @ w_down
    return x, ka, va, s_new


def setup_inputs(seed: int = 0) -> dict:
    key = jax.random.key(seed)
    ks = jax.random.split(key, 24)
    n_pages = PAST_LEN // PAGE_SIZE
    n_used = DEC_BATCH * n_pages
    n_pool = n_used + n_used // 4
    nrm = lambda k, shape, s: jax.random.normal(k, shape, jnp.float32) * s
    gain = lambda k, shape: 1.0 + 0.01 * jax.random.normal(k, shape, jnp.float32)
    page_table = jax.random.permutation(ks[5], n_pool)[:n_used].reshape(DEC_BATCH, n_pages).astype(jnp.int32)
    return {
        "x_prompt": nrm(ks[0], (BATCH, SEQ, D_MODEL), 1.0),
        "x_sample": nrm(ks[1], (DEC_BATCH, DEC_SEQ, D_MODEL), 1.0),
        "cache_k": nrm(ks[2], (DEPTH, n_pool, PAGE_SIZE, A_HEADS, 2, A_HEAD_DIM), 1.0),
        "cache_v": nrm(ks[3], (DEPTH, n_pool, PAGE_SIZE, A_HEADS, 2 * A_HEAD_DIM), 1.0),
        "state_hgrn": nrm(ks[4], (DEPTH, DEC_BATCH, H_HEADS, H_EXPAND, H_EXPAND), 0.3),
        "page_table": page_table,
        "attn_norm": gain(ks[6], (DEPTH, D_MODEL)),
        "w_in": nrm(ks[7], (DEPTH, D_MODEL, N_IN), D_MODEL ** -0.5),
        "w_out": nrm(ks[8], (DEPTH, MIX_A + MIX_H, D_MODEL), (MIX_A + MIX_H) ** -0.5),
        "lambda_q1": nrm(ks[9], (DEPTH, A_HEAD_DIM), 0.1),
        "lambda_k1": nrm(ks[10], (DEPTH, A_HEAD_DIM), 0.1),
        "lambda_q2": nrm(ks[11], (DEPTH, A_HEAD_DIM), 0.1),
        "lambda_k2": nrm(ks[12], (DEPTH, A_HEAD_DIM), 0.1),
        "subln_w": gain(ks[13], (DEPTH, 2 * A_HEAD_DIM)),
        "hgrn_lb_logits": nrm(ks[14], (DEPTH + 1, MIX_H), 0.5),
        "hgrn_norm": gain(ks[15], (DEPTH, MIX_H)),
        "ffn_norm": gain(ks[16], (DEPTH, D_MODEL)),
        "w_gate": nrm(ks[17], (DEPTH, D_MODEL, D_FF), D_MODEL ** -0.5),
        "w_up": nrm(ks[18], (DEPTH, D_MODEL, D_FF), D_MODEL ** -0.5),
        "w_down": nrm(ks[19], (DEPTH, D_FF, D_MODEL), D_FF ** -0.5),
        "final_norm": gain(ks[20], (D_MODEL,)),
    }


def reference(x_prompt, x_sample, cache_k, cache_v, state_hgrn, page_table, attn_norm, w_in, w_out,
              lambda_q1, lambda_k1, lambda_q2, lambda_k2, subln_w, hgrn_lb_logits, hgrn_norm,
              ffn_norm, w_gate, w_up, w_down, final_norm):
    Bd, n_pages = page_table.shape
    past_len = n_pages * cache_k.shape[2]
    pos_p = jnp.arange(x_prompt.shape[1])
    pos_s = past_len + jnp.arange(x_sample.shape[1])
    lb_all = jnp.cumsum(jax.nn.softmax(hgrn_lb_logits.astype(jnp.float32), axis=0), axis=0)
    xp, xs = x_prompt, x_sample
    kp, vp, sp, ks_, vs_, ss = [], [], [], [], [], []
    for l in range(DEPTH):
        lam_init = 0.8 - 0.6 * math.exp(-0.3 * l)
        lam = (jnp.exp(jnp.sum(lambda_q1[l].astype(jnp.float32) * lambda_k1[l].astype(jnp.float32)))
               - jnp.exp(jnp.sum(lambda_q2[l].astype(jnp.float32) * lambda_k2[l].astype(jnp.float32)))
               + lam_init)
        lw = (attn_norm[l], w_in[l], w_out[l], subln_w[l], lam, lam_init, lb_all[l],
              hgrn_norm[l], ffn_norm[l], w_gate[l], w_up[l], w_down[l])
        s0_p = jnp.zeros((xp.shape[0], H_HEADS, H_EXPAND, H_EXPAND), jnp.float32)
        xp, k_new, v_new, s_new = trunk_layer(xp, pos_p, s0_p, diff_attn_prompt, *lw)
        kp.append(k_new); vp.append(v_new); sp.append(s_new)
        k_past = cache_k[l][page_table].reshape(Bd, past_len, A_HEADS, 2, A_HEAD_DIM)
        v_past = cache_v[l][page_table].reshape(Bd, past_len, A_HEADS, 2 * A_HEAD_DIM)
        attend_s = functools.partial(diff_attn_sample, k_past=k_past, v_past=v_past)
        xs, k_new, v_new, s_new = trunk_layer(xs, pos_s, state_hgrn[l].astype(jnp.float32), attend_s, *lw)
        ks_.append(k_new); vs_.append(v_new); ss.append(s_new)
    y_prompt = rmsnorm(xp, final_norm)
    y_sample = rmsnorm(xs, final_norm)
    return (y_prompt, y_sample, jnp.stack(kp), jnp.stack(vp), jnp.stack(sp),
            jnp.stack(ks_), jnp.stack(vs_), jnp.stack(ss))
```

```cpp
#include <hip/hip_runtime.h>
#include <cstdio>
#include <cstdint>
__device__ __forceinline__ int opaque_tid() { int t = threadIdx.x; asm volatile("" : "+v"(t)); return t; }
namespace pg8 {
#define PG8_LAS __attribute__((address_space(3)))
typedef unsigned short bf16_t;
typedef short bf16x8 __attribute__((ext_vector_type(8)));
typedef float f32x4 __attribute__((ext_vector_type(4)));
typedef unsigned u32x4 __attribute__((ext_vector_type(4)));
constexpr int BM = 256, BK = 64, HALF = 128, HTB = HALF * BK * 2  , STAGE_BYTES = 8 * HTB, NXCD = 8, WGM = 8;

__host__ __device__ __forceinline__ int lds_byte(int r, int c) { const int st = (r >> 4) * 2 + (c >> 5), rr = r & 15, cc = c & 31, ob = rr * 64 + cc * 2; return st * 1024 + (ob ^ (((ob >> 9) & 1) << 5)); }
__host__ __device__ __forceinline__ void stage_rc(int b, int& R, int& C) { const int st = b / 1024, sb = b % 1024, swz = sb ^ (((sb >> 9) & 1) << 5); R = (st >> 1) * 16 + swz / 64; C = (st & 1) * 32 + (swz % 64) / 2; }
__host__ __device__ __forceinline__ int perm32(int rho) { const int n = rho >> 4, i = rho & 15; return 8 * (i >> 2) + 4 * n + (i & 3); }

struct Unit { int pm, pn; };
struct Gemm { const bf16_t* A; const bf16_t* Bt; int M, N, K; };

struct StaticOrder {
    int nM, nN, nwg, G, c;
    __host__ __device__ void init(int M, int N, int G_, int c_) { nM = M / BM; nN = N / BM; nwg = nM * nN; G = G_; c = c_; }
    __host__ __device__ bool next(int i, Unit& u) const {
        const long L = (long)i * G + c; if (L >= nwg) return false;
        int wgid = (int)L; { const int q = nwg / NXCD, r = nwg % NXCD, xcd = wgid % NXCD, off = wgid / NXCD; wgid = (xcd < r ? xcd * (q + 1) : r * (q + 1) + (xcd - r) * q) + off; }
        const int nig = WGM * nN, gid = wgid / nig, fm = gid * WGM, gsz = (nM - fm) < WGM ? (nM - fm) : WGM;
        u.pm = fm + ((wgid % nig) % gsz); u.pn = (wgid % nig) / gsz; return true;
    }
    __device__ __forceinline__ void a_ready(const Unit&) const {}
    __device__ __forceinline__ void done(const Unit&) const {}
};

__device__ __forceinline__ unsigned cvt_pk_bf16(float lo, float hi) { unsigned r; asm volatile("v_cvt_pk_bf16_f32 %0, %1, %2" : "=v"(r) : "v"(lo), "v"(hi)); return r; }
typedef float f32x2 __attribute__((ext_vector_type(2)));
__device__ __forceinline__ f32x2 gelu_pk(f32x2 v) {
    const f32x2 av = __builtin_elementwise_abs(v), d = av * 0.2316418882f + 1.0f;
    f32x2 t; t.x = __builtin_amdgcn_rcpf(d.x); t.y = __builtin_amdgcn_rcpf(d.y);
    f32x2 q = t * 0.5307027145f + (-0.7265760135f); q = q * t + 0.7107068705f; q = q * t + (-0.142248368f); q = q * t + 0.127414796f; q = q * t;
    const f32x2 s = (v * v) * (-0.72134752044f);
    f32x2 e; e.x = __builtin_amdgcn_exp2f(s.x); e.y = __builtin_amdgcn_exp2f(s.y);
    const f32x2 m = v * (q * e), r = v - m;
    f32x2 o; o.x = v.x < 0.f ? m.x : r.x; o.y = v.y < 0.f ? m.y : r.y; return o;
}

template <int ACT  > struct EpiBf16 {
    static constexpr bool PERM = true, AFTER_DRAIN = false; static_assert(ACT == 0 || ACT == 1, "EpiBf16: ACT is 0 (none) or 1 (gelu_pk)");
    bf16_t* O; int ldc; const float* bias; int split_cols; size_t split_stride; float scale0;
    __device__ __forceinline__ void operator()(const f32x4 (&acc)[2][2][4][2], const Unit& u, int wr, int wc, int fr, int fq) const {
        const int row0 = u.pm * BM + wr * 64 + fr; int colt = u.pn * BM; bf16_t* base = O;
        float sc = 1.f; if (split_cols) { const int t = colt / split_cols; base += (size_t)t * split_stride; colt -= t * split_cols; if (t == 0) sc = scale0; }
        const int col0 = colt + wc * 32 + 8 * fq, bcol0 = u.pn * BM + wc * 32 + 8 * fq;
        f32x4 bv[2][2];
#pragma unroll
        for (int bj = 0; bj < 2; ++bj)
#pragma unroll
            for (int n = 0; n < 2; ++n) bv[bj][n] = bias ? *(const f32x4*)(bias + bcol0 + bj * HALF + 4 * n) : (f32x4){0.f, 0.f, 0.f, 0.f};
#pragma unroll
        for (int ai = 0; ai < 2; ++ai)
#pragma unroll
            for (int m = 0; m < 4; ++m) { bf16_t* rowp = base + (size_t)(row0 + ai * HALF + m * 16) * ldc + col0;
#pragma unroll
                for (int bj = 0; bj < 2; ++bj) { f32x4 v0 = acc[ai][bj][m][0] + bv[bj][0], v1 = acc[ai][bj][m][1] + bv[bj][1];
                    if (ACT == 1) { f32x2 a = gelu_pk((f32x2){v0[0], v0[1]}), b = gelu_pk((f32x2){v0[2], v0[3]}), c = gelu_pk((f32x2){v1[0], v1[1]}), d = gelu_pk((f32x2){v1[2], v1[3]});
                        v0 = (f32x4){a.x, a.y, b.x, b.y}; v1 = (f32x4){c.x, c.y, d.x, d.y}; }
                    v0 = v0 * sc; v1 = v1 * sc; u32x4 w; w.x = cvt_pk_bf16(v0[0], v0[1]); w.y = cvt_pk_bf16(v0[2], v0[3]); w.z = cvt_pk_bf16(v1[0], v1[1]); w.w = cvt_pk_bf16(v1[2], v1[3]);
                    *(u32x4*)(rowp + bj * HALF) = w; } }
    }
};
template <class Epi, class Sched, bool ALIGN_EPI = false, bool SP2 = false>
__device__ __forceinline__ void gemm_phase(PG8_LAS unsigned char* lds, const Gemm g, const Sched& S, const Epi& E) {
    const int tid = opaque_tid(), wid = __builtin_amdgcn_readfirstlane(tid >> 6), lane = tid & 63, wr = wid >> 2, wc = wid & 3, fr = lane & 15, fq = lane >> 4;
    const int K = g.K, nt = K / BK;
    unsigned voffA[2], voffB[2];
#pragma unroll
    for (int i = 0; i < 2; ++i) { int R, C; stage_rc(tid * 16 + i * 8192, R, C); const int Rb = Epi::PERM ? ((R & ~31) + perm32(R & 31)) : R;
        voffA[i] = (unsigned)(R * K + C) * 2u; voffB[i] = (unsigned)(Rb * K + C) * 2u; }
    const size_t kstep = (size_t)(BK * 2);
    const size_t hstep = (size_t)HALF * K * 2;
    const size_t tstep = 2 * hstep;
    const unsigned ldsw = (unsigned)wid * 1024u;
    const int aoff = lds_byte(wr * 64 + fr, fq * 8), boff = lds_byte(wc * 32 + fr, fq * 8);
#define PG8_SA(b, h) (((b) * 2 + (h)) * HTB)
#define PG8_SB(b, h) ((4 + (b) * 2 + (h)) * HTB)
#define PG8_STAGE(bufoff, gbase, voff) do { _Pragma("unroll") for (int _i = 0; _i < 2; ++_i) \
        __builtin_amdgcn_global_load_lds((const unsigned*)((const char*)(gbase) + (voff)[_i]), (PG8_LAS unsigned*)(lds + (bufoff) + ldsw + _i * 8192), 16, 0, 0); } while (0)
#define PG8_LDA(dst, b, h) do { _Pragma("unroll") for (int m = 0; m < 4; ++m) _Pragma("unroll") for (int k = 0; k < 2; ++k) dst[m][k] = *(const PG8_LAS bf16x8*)(lds + PG8_SA(b, h) + aoff + m * 2048 + k * 1024); } while (0)
#define PG8_LDB(dst, b, h) do { _Pragma("unroll") for (int n = 0; n < 2; ++n) _Pragma("unroll") for (int k = 0; k < 2; ++k) dst[n][k] = *(const PG8_LAS bf16x8*)(lds + PG8_SB(b, h) + boff + n * 2048 + k * 1024); } while (0)
#define PG8_MMA(ai, bj, At, Bt) do { __builtin_amdgcn_s_setprio(1); _Pragma("unroll") for (int m = 0; m < 4; ++m) _Pragma("unroll") for (int n = 0; n < 2; ++n) _Pragma("unroll") for (int k = 0; k < 2; ++k) \
        acc[ai][bj][m][n] = __builtin_amdgcn_mfma_f32_16x16x32_bf16(Bt[n][k], At[m][k], acc[ai][bj][m][n], 0, 0, 0); __builtin_amdgcn_s_setprio(0); } while (0)
#define PG8_WAIT_V(n) asm volatile("s_waitcnt vmcnt(" #n ")" ::: "memory")
#define PG8_WAIT_L(n) asm volatile("s_waitcnt lgkmcnt(" #n ")" ::: "memory")
#define PG8_BAR __builtin_amdgcn_s_barrier()
#define PG8_SCHED __builtin_amdgcn_sched_barrier(0)
    Unit cur, nxt; int ui = 0;
    if (!S.next(0, cur)) return;
    f32x4 acc[2][2][4][2];
#pragma unroll
    for (int a = 0; a < 2; ++a)
#pragma unroll
        for (int b = 0; b < 2; ++b)
#pragma unroll
            for (int m = 0; m < 4; ++m)
#pragma unroll
                for (int n = 0; n < 2; ++n) acc[a][b][m][n] = (f32x4){0.f, 0.f, 0.f, 0.f};
    bf16x8 At[4][2], B0[2][2], B1[2][2];
    const char* cA = (const char*)g.A + (size_t)cur.pm * tstep; const char* cB = (const char*)g.Bt + (size_t)cur.pn * tstep;
    S.a_ready(cur);
    if constexpr (SP2) {
        PG8_STAGE(PG8_SB(0, 0), cB, voffB); PG8_STAGE(PG8_SB(0, 1), cB + hstep, voffB); PG8_STAGE(PG8_SA(0, 0), cA, voffA); PG8_STAGE(PG8_SA(0, 1), cA + hstep, voffA);
        if (wr == 1) PG8_BAR;
        PG8_WAIT_V(2); PG8_BAR;
        PG8_STAGE(PG8_SB(1, 0), cB + kstep, voffB); PG8_STAGE(PG8_SA(1, 0), cA + kstep, voffA); PG8_STAGE(PG8_SB(1, 1), cB + hstep + kstep, voffB);
        PG8_WAIT_V(6); PG8_BAR;
    } else {
        PG8_STAGE(PG8_SB(0, 0), cB, voffB); PG8_STAGE(PG8_SA(0, 0), cA, voffA); PG8_STAGE(PG8_SB(0, 1), cB + hstep, voffB); PG8_STAGE(PG8_SA(0, 1), cA + hstep, voffA);
        if (wr == 1) PG8_BAR;
        PG8_WAIT_V(4); PG8_BAR;
        PG8_STAGE(PG8_SB(1, 0), cB + kstep, voffB); PG8_STAGE(PG8_SA(1, 0), cA + kstep, voffA); PG8_STAGE(PG8_SB(1, 1), cB + hstep + kstep, voffB);
        PG8_WAIT_V(6); PG8_BAR;
    }
    for (;;) {
        const bool has_next = S.next(ui + 1, nxt);
        const char* nA = has_next ? (const char*)g.A + (size_t)nxt.pm * tstep : cA; const char* nB = has_next ? (const char*)g.Bt + (size_t)nxt.pn * tstep : cB;
        for (int t = 0; t < nt; t += 2) {
            const bool last = (t == nt - 2);
            const char* a1 = cA + (size_t)(t + 1) * kstep;
            const char* a2 = last ? nA : cA + (size_t)(t + 2) * kstep; const char* b2 = last ? nB : cB + (size_t)(t + 2) * kstep;
            const char* a3 = a2 + kstep; const char* b3 = b2 + kstep;
            if (last && has_next) S.a_ready(nxt);
            if constexpr (SP2) {
            PG8_LDB(B0, 0, 0); PG8_LDB(B1, 0, 1); PG8_SCHED; PG8_LDA(At, 0, 0); PG8_STAGE(PG8_SA(1, 1), a1 + hstep, voffA);
            PG8_WAIT_V(8); PG8_WAIT_L(0); PG8_BAR; PG8_MMA(0, 0, At, B0); PG8_MMA(0, 1, At, B1); PG8_BAR; PG8_SCHED;
            PG8_LDA(At, 0, 1); PG8_STAGE(PG8_SB(0, 0), b2, voffB); PG8_STAGE(PG8_SB(0, 1), b2 + hstep, voffB); PG8_STAGE(PG8_SA(0, 0), a2, voffA);
            PG8_WAIT_V(8); PG8_WAIT_L(0); PG8_BAR; PG8_MMA(1, 0, At, B0); PG8_MMA(1, 1, At, B1); PG8_BAR; PG8_SCHED;
            PG8_LDB(B0, 1, 0); PG8_LDB(B1, 1, 1); PG8_SCHED; PG8_LDA(At, 1, 0); PG8_STAGE(PG8_SA(0, 1), a2 + hstep, voffA);
            PG8_WAIT_V(8); PG8_WAIT_L(0); PG8_BAR; PG8_MMA(0, 0, At, B0); PG8_MMA(0, 1, At, B1); PG8_BAR; PG8_SCHED;
            PG8_LDA(At, 1, 1); PG8_STAGE(PG8_SB(1, 0), b3, voffB); PG8_STAGE(PG8_SB(1, 1), b3 + hstep, voffB); PG8_STAGE(PG8_SA(1, 0), a3, voffA);
            PG8_WAIT_V(8); PG8_WAIT_L(0); PG8_BAR; PG8_MMA(1, 0, At, B0); PG8_MMA(1, 1, At, B1); PG8_BAR; PG8_SCHED;
            } else {
            PG8_LDB(B0, 0, 0); PG8_SCHED; PG8_LDA(At, 0, 0); PG8_STAGE(PG8_SA(1, 1), a1 + hstep, voffA);
            PG8_WAIT_L(8); PG8_BAR; PG8_WAIT_L(0); PG8_MMA(0, 0, At, B0); PG8_BAR; PG8_SCHED;
            PG8_LDB(B1, 0, 1); PG8_STAGE(PG8_SB(0, 0), b2, voffB);
            PG8_BAR; PG8_WAIT_L(0); PG8_MMA(0, 1, At, B1); PG8_BAR;
            PG8_LDA(At, 0, 1); PG8_STAGE(PG8_SA(0, 0), a2, voffA);
            PG8_BAR; PG8_WAIT_L(0); PG8_MMA(1, 0, At, B0); PG8_BAR; PG8_SCHED;
            PG8_STAGE(PG8_SB(0, 1), b2 + hstep, voffB);
            PG8_WAIT_V(6); PG8_BAR; PG8_MMA(1, 1, At, B1); PG8_BAR;
            PG8_LDB(B0, 1, 0); PG8_SCHED; PG8_LDA(At, 1, 0); PG8_STAGE(PG8_SA(0, 1), a2 + hstep, voffA);
            PG8_WAIT_L(8); PG8_BAR; PG8_WAIT_L(0); PG8_MMA(0, 0, At, B0); PG8_BAR; PG8_SCHED;
            PG8_LDB(B1, 1, 1); PG8_STAGE(PG8_SB(1, 0), b3, voffB);
            PG8_BAR; PG8_WAIT_L(0); PG8_MMA(0, 1, At, B1); PG8_BAR;
            PG8_LDA(At, 1, 1); PG8_STAGE(PG8_SA(1, 0), a3, voffA);
            PG8_BAR; PG8_WAIT_L(0); PG8_MMA(1, 0, At, B0); PG8_BAR; PG8_SCHED;
            PG8_STAGE(PG8_SB(1, 1), b3 + hstep, voffB);
            PG8_WAIT_V(6); PG8_BAR; PG8_MMA(1, 1, At, B1); PG8_BAR;
            }
        }
        if constexpr (ALIGN_EPI) { if (wr == 0) PG8_BAR; }
        if constexpr (!Epi::AFTER_DRAIN) { E(acc, cur, wr, wc, fr, fq); S.done(cur); }
        if (!has_next) break;
#pragma unroll
        for (int a = 0; a < 2; ++a)
#pragma unroll
            for (int b = 0; b < 2; ++b)
#pragma unroll
                for (int m = 0; m < 4; ++m)
#pragma unroll
                    for (int n = 0; n < 2; ++n) acc[a][b][m][n] = (f32x4){0.f, 0.f, 0.f, 0.f};
        cur = nxt; cA = nA; cB = nB; ++ui;
        if constexpr (ALIGN_EPI) { if (wr == 1) PG8_BAR; }
    }
    PG8_WAIT_V(0);
    if constexpr (!ALIGN_EPI) { if (wr == 0) PG8_BAR; }
    PG8_BAR;
    if constexpr (Epi::AFTER_DRAIN) { E.fused(acc, cur, wr, wc, fr, fq, lds, wid, lane); S.done(cur); }
#undef PG8_SA
#undef PG8_SB
#undef PG8_STAGE
#undef PG8_LDA
#undef PG8_LDB
#undef PG8_MMA
#undef PG8_WAIT_V
#undef PG8_WAIT_L
#undef PG8_BAR
#undef PG8_SCHED
}
}

#ifndef PG8_SP2
#define PG8_SP2 true
#endif
#ifndef PG8_ALIGN
#define PG8_ALIGN true
#endif
#include <hip/hip_bf16.h>
#include <cmath>
namespace attn_body {
using bf16=__hip_bfloat16;
using bf16x8=__attribute__((ext_vector_type(8)))short;
using s16x4=__attribute__((ext_vector_type(4)))short;
using f32x16=__attribute__((ext_vector_type(16)))float;
using u32x4=__attribute__((ext_vector_type(4)))unsigned;
constexpr int BATCH=2,NHEAD=16,SEQ=8192,D=64,DM=NHEAD*D;
constexpr int PQK=512, PO=1024;
constexpr int NW=8,QBLK=32,QB=QBLK*NW,KVBLK=64,NQB=SEQ/QB;
constexpr int ATTN_PITCH=DM, ATTN_UNIT_ROWS=QB;
__device__ __forceinline__ int crow(int r,int hi){return (r&3)+8*(r>>2)+4*hi;}
#define SBAR() __builtin_amdgcn_sched_barrier(0)
__device__ __forceinline__ void cmask(f32x16&p0,f32x16&p1,int jb,int qrel,int hi){
  const float NEG=-INFINITY; int kb=64*jb+4*hi;
  #pragma unroll
  for(int r=0;r<16;++r){int kv=kb+(r&3)+8*(r>>2); if(kv>qrel)p0[r]=NEG; if(kv+32>qrel)p1[r]=NEG;}
}

constexpr int NSLOT=3, SLOTB=8192;
constexpr int LDS_K=0, LDS_V=NSLOT*SLOTB, LDS_WS=2*NSLOT*SLOTB, LDS_OST=LDS_WS+NW*64*4, LDS_BYTES=LDS_OST+NW*4096;
constexpr float C2=0.125f*1.4426950408889634f;
__device__ __forceinline__ void glds16(const void*gsrc,unsigned lds_dst){unsigned keep;
  asm volatile("s_mov_b32 %0, m0\n\ts_mov_b32 m0, %2\n\ts_nop 0\n\tglobal_load_lds_dwordx4 %1, off\n\ts_mov_b32 m0, %0":"=&s"(keep):"v"(gsrc),"s"(lds_dst):"memory");}
__device__ __forceinline__ float max3f(float a,float b,float c){float r;asm("v_max3_f32 %0, %1, %2, %3":"=v"(r):"v"(a),"v"(b),"v"(c));return r;}
__device__ __forceinline__ float max2f(float a,float b){float r;asm("v_max_f32_e32 %0, %1, %2":"=v"(r):"v"(a),"v"(b));return r;}
__device__ __forceinline__ float fadd_s(float a,float b){float r;asm("v_add_f32_e32 %0, %1, %2":"=v"(r):"v"(a),"v"(b));return r;}
__device__ __forceinline__ float fsub_s(float a,float b){float r;asm("v_sub_f32_e32 %0, %1, %2":"=v"(r):"v"(a),"v"(b));return r;}
typedef float f32x2_t __attribute__((ext_vector_type(2))); typedef __bf16 bf16x2_t __attribute__((ext_vector_type(2)));
__device__ __forceinline__ unsigned cvtpk_s(float lo,float hi){f32x2_t v={lo,hi};bf16x2_t b=__builtin_convertvector(v,bf16x2_t);return __builtin_bit_cast(unsigned,b);}
#define WAIT_BAR(N) asm volatile("s_waitcnt vmcnt(" #N ") lgkmcnt(0)\n\ts_barrier":::"memory")

__device__ __forceinline__ void qkt(f32x16&p0,f32x16&p1,const char*Kslot,const bf16x8*qr,const f32x16&negm,int r32,int hi){
  const char*kb=Kslot+hi*1024+r32*16;
  #pragma unroll
  for(int d0=0;d0<4;++d0){
    const bf16x8 b0=*reinterpret_cast<const bf16x8*>(kb+d0*2048);
    const bf16x8 b1=*reinterpret_cast<const bf16x8*>(kb+d0*2048+512);
    if(d0==0){p0=__builtin_amdgcn_mfma_f32_32x32x16_bf16(b0,qr[0],negm,0,0,0);p1=__builtin_amdgcn_mfma_f32_32x32x16_bf16(b1,qr[0],negm,0,0,0);}
    else{p0=__builtin_amdgcn_mfma_f32_32x32x16_bf16(b0,qr[d0],p0,0,0,0);p1=__builtin_amdgcn_mfma_f32_32x32x16_bf16(b1,qr[d0],p1,0,0,0);}}
}
typedef __attribute__((address_space(3))) const char* lds_cptr;
typedef short v4i16_t __attribute__((ext_vector_type(4)));
__device__ __forceinline__ void kload8(bf16x8*kf,lds_cptr kp){
  kf[0]=*(const __attribute__((address_space(3))) bf16x8*)(kp);      kf[1]=*(const __attribute__((address_space(3))) bf16x8*)(kp+512);
  kf[2]=*(const __attribute__((address_space(3))) bf16x8*)(kp+2048); kf[3]=*(const __attribute__((address_space(3))) bf16x8*)(kp+2560);
  kf[4]=*(const __attribute__((address_space(3))) bf16x8*)(kp+4096); kf[5]=*(const __attribute__((address_space(3))) bf16x8*)(kp+4608);
  kf[6]=*(const __attribute__((address_space(3))) bf16x8*)(kp+6144); kf[7]=*(const __attribute__((address_space(3))) bf16x8*)(kp+6656);
}
__device__ __forceinline__ void kload2(bf16x8*kf,lds_cptr kp,int j){ kf[2*j]=*(const __attribute__((address_space(3))) bf16x8*)(kp+j*2048); kf[2*j+1]=*(const __attribute__((address_space(3))) bf16x8*)(kp+j*2048+512); }
__device__ __forceinline__ s16x4 vtr(lds_cptr p){ return __builtin_bit_cast(s16x4,__builtin_amdgcn_ds_read_tr16_b64_v4i16((__attribute__((address_space(3))) v4i16_t*)p)); }
__device__ __forceinline__ float rowmax(const f32x16&p0,const f32x16&p1){
  float a=max3f(p0[0],p0[1],p1[0]),b=max3f(p0[2],p0[3],p1[1]);a=max3f(a,p1[2],p1[3]);
  #pragma unroll
  for(int r=4;r<16;r+=4){a=max3f(a,p0[r],p0[r+1]);b=max3f(b,p0[r+2],p0[r+3]);a=max3f(a,p1[r],p1[r+1]);b=max3f(b,p1[r+2],p1[r+3]);}
  const float m=max2f(a,b);
  auto rr=__builtin_amdgcn_permlane32_swap(__float_as_uint(m),__float_as_uint(m),false,false);
  return max2f(__uint_as_float(rr[0]),__uint_as_float(rr[1]));
}
__device__ __forceinline__ void pv(f32x16*o,int vb,bf16x8 pa0,bf16x8 pa1,bf16x8 pa2,bf16x8 pa3){
  #pragma unroll
  for(int d0=0;d0<2;++d0){s16x4 lo[4],hi[4];
    #pragma unroll
    for(int ks=0;ks<4;++ks){
      asm volatile("ds_read_b64_tr_b16 %0,%1 offset:%c2":"=&v"(lo[ks]):"v"(vb),"i"(d0*4096+ks*1024):"memory");
      asm volatile("ds_read_b64_tr_b16 %0,%1 offset:%c2":"=&v"(hi[ks]):"v"(vb),"i"(d0*4096+ks*1024+512):"memory");}
    asm volatile("s_waitcnt lgkmcnt(0)":::"memory");SBAR();
    #define PK(k) (bf16x8){lo[k][0],lo[k][1],lo[k][2],lo[k][3],hi[k][0],hi[k][1],hi[k][2],hi[k][3]}
    o[d0]=__builtin_amdgcn_mfma_f32_32x32x16_bf16(pa0,PK(0),o[d0],0,0,0);
    o[d0]=__builtin_amdgcn_mfma_f32_32x32x16_bf16(pa1,PK(1),o[d0],0,0,0);
    o[d0]=__builtin_amdgcn_mfma_f32_32x32x16_bf16(pa2,PK(2),o[d0],0,0,0);
    o[d0]=__builtin_amdgcn_mfma_f32_32x32x16_bf16(pa3,PK(3),o[d0],0,0,0);
    #undef PK
  }
}

#ifndef ATTN_STORE16
#define ATTN_STORE16(p,v) (*(u32x4*)(p)=(v))
#endif
template<int THRL> __device__ __forceinline__ void attn_unit(int b,int h,int qb,const bf16*Q,const bf16*__restrict__ K,const bf16*__restrict__ V,bf16*O,char*shm){
  const int tid=opaque_tid(),lane=tid&63,r32=lane&31,hi=lane>>5; const int wid=__builtin_amdgcn_readfirstlane(tid>>6);
  const long rowbase=(long)b*SEQ; const int q0=qb*QB;
  const int qkcol=(h>>2)*128+((h>>1)&1)*64, vcol=(h>>2)*128+(h&1)*64;
  const bf16*Qw=Q+(rowbase+q0+wid*QBLK)*PQK+qkcol;
  const bf16*Kh=K+rowbase*PQK+qkcol,*Vh=V+rowbase*PQK+vcol;
  const unsigned lds0=(unsigned)(uintptr_t)shm;
  float*wsf=(float*)(shm+LDS_WS)+wid*64;
  const bf16*ksrc=Kh+(long)lane*PQK+wid*8;
  const bf16*vsrc=Vh+(long)(16*(wid&3)+(lane>>2))*PQK+(wid>>2)*32+(lane&3)*8;
  const unsigned kdst=lds0+LDS_K+wid*1024, vdst=lds0+LDS_V+wid*1024;
  #define DMA_K(t,slot) glds16(ksrc+(long)(t)*KVBLK*PQK,(unsigned)__builtin_amdgcn_readfirstlane(kdst+(slot)))
  #define DMA_V(t,slot) glds16(vsrc+(long)(t)*KVBLK*PQK,(unsigned)__builtin_amdgcn_readfirstlane(vdst+(slot)))
  const int vb0=(int)(lds0+LDS_V)+((lane>>4)&1)*32+(lane&3)*8+(4*hi+((lane&15)>>2))*64;
  const char*Kbase=shm+LDS_K; bf16x8 kf[8];
  const lds_cptr shm3=(lds_cptr)shm; const lds_cptr kp0=shm3+LDS_K+hi*1024+r32*16; const lds_cptr vp0=shm3+LDS_V+((lane>>4)&1)*32+(lane&3)*8+(4*hi+((lane&15)>>2))*64;
  const int NT=(q0+QB)/KVBLK;
  DMA_K(0,0);DMA_V(0,0);DMA_K(1,SLOTB);
  bf16x8 qr[4];
  #pragma unroll
  for(int d0=0;d0<4;++d0)qr[d0]=*reinterpret_cast<const bf16x8*>(&Qw[(long)r32*PQK+d0*16+hi*8]);
  float mhat=0.f,l_reg=0.f;f32x16 o[2];o[0]=f32x16{};o[1]=f32x16{};f32x16 negm=f32x16{};asm volatile("":"+v"(negm));
  const int qrel=wid*QBLK+r32;
  #define CMASK(P0,P1,t) do{int jb_=(t)-(NT-4); if(jb_>=0)cmask(P0,P1,jb_,qrel,hi);}while(0)
  bool resc=false;
  #define START(P0,P1) do{ const float rm=rowmax(P0,P1); resc=false; \
    { const float dl=rm; mhat=fadd_s(mhat,dl); \
      _Pragma("unroll") for(int r=0;r<16;++r){P0[r]=fsub_s(P0[r],dl);P1[r]=fsub_s(P1[r],dl);} \
      _Pragma("unroll") for(int r=0;r<16;++r)negm[r]=-mhat; asm volatile("":"+v"(negm)); } \
    _Pragma("unroll") for(int r=0;r<16;++r)P0[r]=__builtin_amdgcn_exp2f(P0[r]); }while(0)
  #define RESC() do{ if(resc){ asm volatile("s_waitcnt lgkmcnt(0)":::"memory"); \
      _Pragma("unroll") for(int d_=0;d_<2;++d_) _Pragma("unroll") for(int r=0;r<16;++r)o[d_][r]*=wsf[crow(r,hi)]; } }while(0)
  f32x16 pA0,pA1,pB0,pB1;
  int sl_prev=0,sl_cur=0,sl_next=SLOTB;
  #define ROT() do{sl_prev=sl_cur;sl_cur=sl_next;sl_next=(sl_next==(NSLOT-1)*SLOTB)?0:sl_next+SLOTB;}while(0)
  DMA_K(2,2*SLOTB);
  WAIT_BAR(3);
  qkt(pA0,pA1,Kbase,qr,negm,r32,hi);asm volatile("s_nop 15\n\ts_nop 7":"+v"(pA0),"+v"(pA1));CMASK(pA0,pA1,0);
  START(pA0,pA1);
  _Pragma("unroll") for(int r=0;r<16;++r)pA1[r]=__builtin_amdgcn_exp2f(pA1[r]);
  WAIT_BAR(0);
  DMA_K(3,0);DMA_V(1,SLOTB);
  ROT();
  kload8(kf,kp0+sl_cur);
  WAIT_BAR(2);
  s16x4 vlo[8],vhi[8]; u32x4 pw0,pw1,pw2,pw3;
  #define PKW(P,B) cvtpk_s(P[B],P[B+1])
  #define PAF(k) __builtin_bit_cast(bf16x8,pw##k)
  #define VFR(i) (bf16x8){vlo[i][0],vlo[i][1],vlo[i][2],vlo[i][3],vhi[i][0],vhi[i][1],vhi[i][2],vhi[i][3]}
  #define PIN(x) asm volatile("":"+v"(x))
  #define MX3(a,b,c) __builtin_fmaxf(__builtin_fmaxf((a),(b)),(c))
  #define GAPA(MF,A0,A1,A2,A3,W0,W1,PW) do{ MF; sacc+=A0; sacc+=A1; sacc+=A2; sacc+=A3; PIN(sacc); W0; W1; PIN(PW); SBAR(); }while(0)
  #define EX(v) __builtin_amdgcn_exp2f(v)
  #define GAPB(MF,X,B) do{ MF; X[B]=EX(X[B]); X[B+1]=EX(X[B+1]); X[B+2]=EX(X[B+2]); X[B+3]=EX(X[B+3]); PIN(X); SBAR(); }while(0)
  #define VRD(i) do{ vlo[i]=vtr(vp_+(((i)>>2)*4096+((i)&3)*1024)); vhi[i]=vtr(vp_+(((i)>>2)*4096+((i)&3)*1024+512)); }while(0)
  #define KRD(G,j) do{ if(G){ kload2(kf,kp0+sl_next,j); SBAR(); } }while(0)
  #define STEP(C0,C1,P0,P1,t,GK,GV,GL) do{ SBAR(); \
    const lds_cptr vp_=vp0+sl_prev; \
    VRD(0); SBAR(); float sacc=(P0[0]+P0[1]); \
    GAPA(C0=__builtin_amdgcn_mfma_f32_32x32x16_bf16(kf[0],qr[0],negm,0,0,0), P0[2],P0[3],P0[4],P0[5],     pw0[0]=PKW(P0,0), pw0[1]=PKW(P0,2), pw0); \
    VRD(4); SBAR(); GAPA(C1=__builtin_amdgcn_mfma_f32_32x32x16_bf16(kf[1],qr[0],negm,0,0,0), P0[6],P0[7],P0[8],P0[9],     pw0[2]=PKW(P0,4), pw0[3]=PKW(P0,6), pw0); \
    VRD(1); SBAR(); GAPA(C0=__builtin_amdgcn_mfma_f32_32x32x16_bf16(kf[2],qr[1],C0,0,0,0),   P0[10],P0[11],P0[12],P0[13], pw1[0]=PKW(P0,8), pw1[1]=PKW(P0,10), pw1); \
    VRD(5); SBAR(); GAPA(C1=__builtin_amdgcn_mfma_f32_32x32x16_bf16(kf[3],qr[1],C1,0,0,0),   P0[14],P0[15],P1[0],P1[1],   pw1[2]=PKW(P0,12),pw1[3]=PKW(P0,14), pw1); \
    VRD(2); SBAR(); GAPA(C0=__builtin_amdgcn_mfma_f32_32x32x16_bf16(kf[4],qr[2],C0,0,0,0),   P1[2],P1[3],P1[4],P1[5],     pw2[0]=PKW(P1,0), pw2[1]=PKW(P1,2), pw2); \
    VRD(6); SBAR(); GAPA(C1=__builtin_amdgcn_mfma_f32_32x32x16_bf16(kf[5],qr[2],C1,0,0,0),   P1[6],P1[7],P1[8],P1[9],     pw2[2]=PKW(P1,4), pw2[3]=PKW(P1,6), pw2); \
    VRD(3); SBAR(); GAPA(C0=__builtin_amdgcn_mfma_f32_32x32x16_bf16(kf[6],qr[3],C0,0,0,0),   P1[10],P1[11],P1[12],P1[13], pw3[0]=PKW(P1,8), pw3[1]=PKW(P1,10), pw3); \
    VRD(7); SBAR(); GAPA(C1=__builtin_amdgcn_mfma_f32_32x32x16_bf16(kf[7],qr[3],C1,0,0,0),   P1[14],P1[15],0.f,0.f,       pw3[2]=PKW(P1,12),pw3[3]=PKW(P1,14), pw3); \
    l_reg+=sacc; \
    if(GK){DMA_K((t)+3,sl_cur);} if(GV){DMA_V((t)+1,sl_next);} \
    CMASK(C0,C1,t); \
    { float a=MX3(C0[0],C0[1],C1[0]),b=MX3(C0[2],C0[3],C1[1]); a=MX3(a,C1[2],C1[3]); \
      _Pragma("unroll") for(int r=4;r<16;r+=4){a=MX3(a,C0[r],C0[r+1]);b=MX3(b,C0[r+2],C0[r+3]);a=MX3(a,C1[r],C1[r+1]);b=MX3(b,C1[r+2],C1[r+3]);} \
      float rm=__builtin_fmaxf(a,b); { auto rr=__builtin_amdgcn_permlane32_swap(__float_as_uint(rm),__float_as_uint(rm),false,false); rm=__builtin_fmaxf(__uint_as_float(rr[0]),__uint_as_float(rr[1])); } \
      resc=false; \
      if(__builtin_expect(__any(rm>(float)THRL),0)){ const float dl=__builtin_fmaxf(rm,0.f); mhat+=dl; \
        _Pragma("unroll") for(int r=0;r<16;++r){C0[r]-=dl;C1[r]-=dl;} \
        _Pragma("unroll") for(int r=0;r<16;++r)negm[r]=-mhat; asm volatile("":"+v"(negm)); \
        const float f=__builtin_amdgcn_exp2f(-dl); l_reg*=f; if(hi==0)wsf[r32]=f; resc=true; } } \
    SBAR(); \
    GAPB(o[0]=__builtin_amdgcn_mfma_f32_32x32x16_bf16(PAF(0),VFR(0),o[0],0,0,0), C0,0); \
    GAPB(o[1]=__builtin_amdgcn_mfma_f32_32x32x16_bf16(PAF(0),VFR(4),o[1],0,0,0), C0,4); \
    KRD(GL,0); GAPB(o[0]=__builtin_amdgcn_mfma_f32_32x32x16_bf16(PAF(1),VFR(1),o[0],0,0,0), C0,8); \
    KRD(GL,1); GAPB(o[1]=__builtin_amdgcn_mfma_f32_32x32x16_bf16(PAF(1),VFR(5),o[1],0,0,0), C0,12); \
    KRD(GL,2); GAPB(o[0]=__builtin_amdgcn_mfma_f32_32x32x16_bf16(PAF(2),VFR(2),o[0],0,0,0), C1,0); \
    KRD(GL,3); GAPB(o[1]=__builtin_amdgcn_mfma_f32_32x32x16_bf16(PAF(2),VFR(6),o[1],0,0,0), C1,4); \
    GAPB(o[0]=__builtin_amdgcn_mfma_f32_32x32x16_bf16(PAF(3),VFR(3),o[0],0,0,0), C1,8); \
    GAPB(o[1]=__builtin_amdgcn_mfma_f32_32x32x16_bf16(PAF(3),VFR(7),o[1],0,0,0), C1,12); \
    }while(0)
  int t=1;
  #undef CMASK
  #define CMASK(P0,P1,t) do{}while(0)
  for(;t+5<NT;t+=2){
    STEP(pB0,pB1,pA0,pA1,t,true,true,true);     WAIT_BAR(2); RESC(); ROT();
    STEP(pA0,pA1,pB0,pB1,t+1,true,true,true);   WAIT_BAR(2); RESC(); ROT();
  }
  #undef CMASK
  #define CMASK(P0,P1,t) do{int jb_=(t)-(NT-4); if(jb_>=0)cmask(P0,P1,jb_,qrel,hi);}while(0)
  #define ENDW(tt) do{ if((tt)+3<NT){WAIT_BAR(2);} else if((tt)+2<NT){WAIT_BAR(1);} else {WAIT_BAR(0);} }while(0)
  for(;t+1<NT;t+=2){
    STEP(pB0,pB1,pA0,pA1,t,(t+3<NT),(t+1<NT),(t+1<NT));       ENDW(t);   RESC(); ROT();
    STEP(pA0,pA1,pB0,pB1,t+1,(t+4<NT),(t+2<NT),(t+2<NT));     ENDW(t+1); RESC(); ROT();
  }
  STEP(pB0,pB1,pA0,pA1,NT-1,false,false,false); RESC();
  { float sacc=pB0[0]+pB0[1]; _Pragma("unroll") for(int r=2;r<16;++r)sacc+=pB0[r]; _Pragma("unroll") for(int r=0;r<16;++r)sacc+=pB1[r]; l_reg+=sacc;
    pw0=(u32x4){PKW(pB0,0),PKW(pB0,2),PKW(pB0,4),PKW(pB0,6)};pw1=(u32x4){PKW(pB0,8),PKW(pB0,10),PKW(pB0,12),PKW(pB0,14)};pw2=(u32x4){PKW(pB1,0),PKW(pB1,2),PKW(pB1,4),PKW(pB1,6)};pw3=(u32x4){PKW(pB1,8),PKW(pB1,10),PKW(pB1,12),PKW(pB1,14)};
    SBAR(); pv(o,vb0+sl_cur,PAF(0),PAF(1),PAF(2),PAF(3)); }
  #undef PKW
  #undef PAF
  #undef VFR
  #undef PIN
  #undef MX3
  #undef GAPA
  #undef GAPB
  #undef EX
  #undef VRD
  #undef KRD
  #undef STEP
  #undef ENDW
  {auto rr=__builtin_amdgcn_permlane32_swap(__float_as_uint(l_reg),__float_as_uint(l_reg),false,false);l_reg=__uint_as_float(rr[0])+__uint_as_float(rr[1]);}
  if(hi==0)wsf[32+r32]=l_reg;asm volatile("s_waitcnt lgkmcnt(0)":::"memory");
  float rli[16];
  #pragma unroll
  for(int r=0;r<16;++r)rli[r]=__builtin_amdgcn_rcpf(wsf[32+crow(r,hi)]);
  bf16*Ow=O+(rowbase+q0+wid*QBLK)*PO+h*D;
  { bf16*stg=(bf16*)(shm+LDS_OST)+wid*2048;
    #pragma unroll
    for(int r=0;r<16;++r){const int orow=crow(r,hi);
      #pragma unroll
      for(int d0=0;d0<2;++d0)stg[orow*64+d0*32+r32]=__float2bfloat16(o[d0][r]*rli[r]);}
    asm volatile("s_waitcnt lgkmcnt(0)":::"memory");
    #pragma unroll
    for(int i=0;i<4;++i){const int row=i*8+(lane>>3),ch=lane&7; const u32x4 v=*(const u32x4*)(stg+row*64+ch*8); ATTN_STORE16(Ow+(long)row*PO+ch*8,v);} }
  asm volatile("s_waitcnt lgkmcnt(0)\n\ts_barrier":::"memory");
  #undef DMA_K
  #undef DMA_V
  #undef CMASK
  #undef START
  #undef RESC
  #undef ROT
}
constexpr int ATTN_LDS_BYTES=LDS_BYTES;
struct AttnTensors { const bf16* Q; const bf16* K; const bf16* V; bf16* O; };
struct AttnUnit { int bh; int qb; };
struct StaticOrder {
  int vcu;
  __device__ __forceinline__ explicit StaticOrder(int grid,int block):vcu((block%8)*(grid/8)+block/8){}
  __device__ __forceinline__ bool next(int i,AttnUnit&u)const{ if(i>=4)return false; const int s=vcu&7; u.bh=vcu>>3; u.qb=(i==0)?s:(i==1)?15-s:(i==2)?16+s:31-s; return true; }
  __device__ __forceinline__ void a_ready(const AttnUnit&)const{}
  __device__ __forceinline__ void done(const AttnUnit&)const{}
};
template<class Sched,int THRL=8> __device__ __forceinline__ void attn_phase(char*lds,const AttnTensors&T,const Sched&S){
  AttnUnit u;
  for(int i=0;S.next(i,u);++i){ S.a_ready(u); attn_unit<THRL>(u.bh/NHEAD,u.bh%NHEAD,u.qb,T.Q,T.K,T.V,T.O,lds); S.done(u); }
}
#undef SBAR
#undef WAIT_BAR
}
#define GAS __attribute__((address_space(1)))
#define LAS __attribute__((address_space(3)))
typedef unsigned short bf16;
typedef unsigned v4u __attribute__((ext_vector_type(4)));
typedef float f32x4 __attribute__((ext_vector_type(4)));
typedef short bf16x8 __attribute__((ext_vector_type(8)));
typedef GAS unsigned gu32;
typedef GAS unsigned long long gu64;
#define RLX_AGENT __ATOMIC_RELAXED, __HIP_MEMORY_SCOPE_AGENT
#define LDS_WAIT() asm volatile("s_waitcnt lgkmcnt(0)" ::: "memory")
#define VM_WAIT() asm volatile("s_waitcnt vmcnt(0)" ::: "memory")
__device__ __forceinline__ unsigned long long rt() { return __builtin_amdgcn_s_memrealtime(); }
__device__ __forceinline__ unsigned f2bf(float f) { unsigned u = __builtin_bit_cast(unsigned, f); return (u + 0x7fffu + ((u >> 16) & 1u)) >> 16; }
__device__ __forceinline__ unsigned pk2(float lo, float hi) { return f2bf(lo) | (f2bf(hi) << 16); }

#define XB_TMO      128
#define XB_XCNT(j)  (256  + 64 * (j))
#define XB_XSUB(j)  (1280 + 64 * (j))
#define XB_XGEN(j)  (2304 + 64 * (j))
#define XB_TOP      3328
#define XB_TOPGEN   3392
#define XCD_BAR_WORDS 3456
#define XB_SPIN_CAP (1u << 18)

__device__ __forceinline__ unsigned xb_ld(unsigned* p)              { return __hip_atomic_load(p, __ATOMIC_RELAXED, __HIP_MEMORY_SCOPE_AGENT); }
__device__ __forceinline__ unsigned xb_add(unsigned* p, unsigned v) { return __hip_atomic_fetch_add(p, v, __ATOMIC_RELAXED, __HIP_MEMORY_SCOPE_AGENT); }
__device__ __forceinline__ unsigned xb_xcc_id() { return (unsigned)__builtin_amdgcn_s_getreg((3 << 11) | 20) & 0xFu; }
#define XB_SPIN(cond, bar) do { unsigned _sp = 0; while (cond) { __builtin_amdgcn_s_sleep(1); \
    if ((++_sp & 255u) == 0u) { if (xb_ld(&(bar)[XB_TMO])) break; if (_sp > XB_SPIN_CAP) { atomicAdd(&(bar)[XB_TMO], 1u); break; } } } } while (0)

struct XcdBarrier {
    unsigned* bar; unsigned x;
    volatile LAS unsigned* st;
};

__device__ __forceinline__ XcdBarrier xcd_barrier_post(unsigned* bar, volatile LAS unsigned* st) {
    XcdBarrier b; b.bar = bar; b.x = xb_xcc_id(); b.st = st;
    if (threadIdx.x == 0) (void)xb_add(&bar[XB_XCNT(b.x)], 1u);
    return b;
}
__device__ __forceinline__ void xcd_barrier_complete(unsigned* bar, unsigned x, unsigned& nloc, unsigned& nx) {
    const unsigned G = gridDim.x * gridDim.y * gridDim.z;
    unsigned sum, cnt, mine, sp = 0u;
    for (;;) {
        sum = 0u; cnt = 0u; mine = 0u;
#pragma unroll
        for (unsigned j = 0; j < 16; ++j) { const unsigned c = xb_ld(&bar[XB_XCNT(j)]); sum += c; cnt += (c > 0u) ? 1u : 0u; mine = (j == x) ? c : mine; }
        if (sum == G) break;
        __builtin_amdgcn_s_sleep(1);
        if ((++sp & 255u) == 0u) { if (xb_ld(&bar[XB_TMO])) break; if (sp > XB_SPIN_CAP) { atomicAdd(&bar[XB_TMO], 1u); break; } }
    }
    nloc = mine > 0u ? mine : 1u; nx = cnt > 0u ? cnt : 1u;
}

__device__ __forceinline__ void xcd_barrier(const XcdBarrier& b) {
    asm volatile("s_waitcnt vmcnt(0)" ::: "memory");
    __syncthreads();
    if (threadIdx.x == 0) {
        unsigned* bar = b.bar;
        __builtin_amdgcn_s_waitcnt(0);
        unsigned nloc = b.st[0], nx = b.st[1];
        if (nloc == 0u) { xcd_barrier_complete(bar, b.x, nloc, nx); b.st[0] = nloc; b.st[1] = nx; }
        const unsigned old = xb_add(&bar[XB_XSUB(b.x)], 1u);
        const unsigned gen = old / nloc;
        if (old + 1u == (gen + 1u) * nloc) {
            __builtin_amdgcn_fence(__ATOMIC_RELEASE, "agent");
            asm volatile("s_waitcnt vmcnt(0)" ::: "memory");
            const unsigned og = xb_add(&bar[XB_TOP], 1u);
            const unsigned tg = og / nx;
            if (og + 1u == (tg + 1u) * nx) xb_add(&bar[XB_TOPGEN], 1u);
            else XB_SPIN(xb_ld(&bar[XB_TOPGEN]) == tg, bar);
            __builtin_amdgcn_fence(__ATOMIC_ACQUIRE, "agent");
            xb_add(&bar[XB_XGEN(b.x)], 1u);
            asm volatile("s_waitcnt vmcnt(0)" ::: "memory");
        } else {
            XB_SPIN(xb_ld(&bar[XB_XGEN(b.x)]) == gen, bar);
            __builtin_amdgcn_fence(__ATOMIC_ACQUIRE, "agent");
            asm volatile("s_waitcnt vmcnt(0)" ::: "memory");
        }
    }
    __syncthreads();
}
constexpr int NWAVES = 8, NTHR = 512;
constexpr int DM = 1024, SEQ = 8192, MP = 16384, MS = 512, MT = MP + MS;
constexpr int NIN = 3584, DFF = 2816, NGU = 2 * DFF, HW = 512;
constexpr float RMS_EPS = 1e-6f, SUBLN_EPS = 1e-5f, ONE_MINUS_LAM_INIT = 0.8f, LAM_INIT = 0.2f;
constexpr float QSCALE = 0.125f * 1.4426950408889634f;
constexpr size_t OY = 0, OKP = 17301504, OVP = 25690112, OSP = 34078720, OKS = 34209792, OVS = 34471936, OSS = 34734080;
constexpr size_t MiB = 1u << 20;
constexpr size_t WS_CTL = 0, CTL_ZERO_BYTES = 1 * MiB;
constexpr size_t WS_SCAL = 1 * MiB, WS_ROPE = 2 * MiB;
constexpr size_t WS_WIN = 4 * MiB, WS_WOUT = 12 * MiB, WS_WGU = 14 * MiB, WS_WDN = 26 * MiB;
constexpr size_t WS_XN = 32 * MiB, WS_Q = 66 * MiB, WS_K = 84 * MiB, WS_V = 102 * MiB, WS_QH = 120 * MiB, WS_KH = 138 * MiB, WS_VH = 156 * MiB, WS_GH = 174 * MiB;
constexpr size_t WS_LF = 192 * MiB, WS_O16 = 226 * MiB, WS_HU = 260 * MiB, WS_HS = 292 * MiB, WS_HD = 324 * MiB, WS_OHS = 326 * MiB, WS_MIX = 328 * MiB;
constexpr size_t WS_X1 = 362 * MiB, WS_ACT = 430 * MiB, WS_END = 522 * MiB;
constexpr int CW_TMO = 0, CW_BAR = 4096;
constexpr int RING_OFF = 0, RING_BYTES = 131072, LDSCTL_OFF = RING_BYTES, MISC_OFF = LDSCTL_OFF + 320, LDS_BYTES = 147456;

typedef unsigned u32x2 __attribute__((ext_vector_type(2)));
__device__ __forceinline__ float wave_sum(float v) {
#pragma unroll
    for (int o = 1; o < 64; o <<= 1) v += __shfl_xor(v, o);
    return v;
}
__device__ __forceinline__ float bf2f(unsigned short b) { return __uint_as_float((unsigned)b << 16); }
__device__ __forceinline__ float sigmoidf_(float z) { return 1.f / (1.f + __expf(-z)); }
__device__ __forceinline__ f32x4 mfma16(bf16x8 a, bf16x8 b, f32x4 c) { return __builtin_amdgcn_mfma_f32_16x16x32_bf16(a, b, c, 0, 0, 0); }

struct Args { const float* in[21]; float* out; unsigned char* ws; };

__device__ __forceinline__ void p0_transpose_blk(const float* W, int K, int N, bf16* WT, int k0, int n0, int drow0, LAS float* scr, int lane) {
#pragma unroll 8
    for (int i = 0; i < 32; ++i) { const int kk = 2 * i + (lane >> 5); scr[kk * 33 + (lane & 31)] = W[(size_t)(k0 + kk) * N + n0 + (lane & 31)]; }
    LDS_WAIT(); asm volatile("" ::: "memory");
    const int c = lane & 7;
#pragma unroll
    for (int j = 0; j < 4; ++j) { const int n = (lane >> 3) + 8 * j; const LAS float* s = scr + (8 * c) * 33 + n;
        v4u o; o.x = pk2(s[0 * 33], s[1 * 33]); o.y = pk2(s[2 * 33], s[3 * 33]); o.z = pk2(s[4 * 33], s[5 * 33]); o.w = pk2(s[6 * 33], s[7 * 33]);
        *(GAS v4u*)(WT + (size_t)(drow0 + n) * K + k0 + 8 * c) = o; }
    LDS_WAIT(); asm volatile("" ::: "memory");
}
__device__ __forceinline__ void rms_row_to_bf16(const float* xrow, const float* gain, bf16* orow, int lane) {
    const GAS f32x4* xr = (const GAS f32x4*)xrow + lane; const GAS f32x4* gr = (const GAS f32x4*)gain + lane;
    f32x4 v[4]; float s = 0.f;
#pragma unroll
    for (int j = 0; j < 4; ++j) { v[j] = xr[64 * j]; s += (v[j].x * v[j].x + v[j].y * v[j].y) + (v[j].z * v[j].z + v[j].w * v[j].w); }
    const float rstd = 1.f / sqrtf(wave_sum(s) * (1.f / DM) + RMS_EPS);
    GAS unsigned long long* o8 = (GAS unsigned long long*)orow + lane;
#pragma unroll
    for (int j = 0; j < 4; ++j) { const f32x4 g = gr[64 * j];
        o8[64 * j] = (unsigned long long)pk2(v[j].x * rstd * g.x, v[j].y * rstd * g.y) | ((unsigned long long)pk2(v[j].z * rstd * g.z, v[j].w * rstd * g.w) << 32); }
}
__device__ __forceinline__ void p0_prologue(const Args& a, LAS unsigned char* lds, int vcu, int G, int tid, int lane, int wave) {
    unsigned char* ws = a.ws;
    LAS float* scr = (LAS float*)(lds + RING_OFF + wave * 16384);
    const int gw = vcu * NWAVES + wave, NGW = G * NWAVES;
    constexpr int I_IN = 16 * 112, I_OUT = 16 * 32, I_G = 16 * 88, I_DN = 44 * 32, NITEMS = I_IN + I_OUT + 2 * I_G + I_DN;
    for (int it = gw; it < NITEMS; it += NGW) {
        int r = it;
        if (r < I_IN) { const int kb = r / 112, nb = r % 112; p0_transpose_blk(a.in[7], DM, NIN, (bf16*)(ws + WS_WIN), 64 * kb, 32 * nb, 32 * nb, scr, lane); continue; } r -= I_IN;
        if (r < I_OUT) { const int kb = r / 32, nb = r % 32; p0_transpose_blk(a.in[8], DM, DM, (bf16*)(ws + WS_WOUT), 64 * kb, 32 * nb, 32 * nb, scr, lane); continue; } r -= I_OUT;
        if (r < I_G) { const int kb = r / 88, nb = r % 88, n0 = 32 * nb; p0_transpose_blk(a.in[17], DM, DFF, (bf16*)(ws + WS_WGU), 64 * kb, n0, (n0 >> 7) * 256 + (n0 & 127), scr, lane); continue; } r -= I_G;
        if (r < I_G) { const int kb = r / 88, nb = r % 88, n0 = 32 * nb; p0_transpose_blk(a.in[18], DM, DFF, (bf16*)(ws + WS_WGU), 64 * kb, n0, (n0 >> 7) * 256 + 128 + (n0 & 127), scr, lane); continue; } r -= I_G;
        { const int kb = r / 32, nb = r % 32; p0_transpose_blk(a.in[19], DFF, DM, (bf16*)(ws + WS_WDN), 64 * kb, 32 * nb, 32 * nb, scr, lane); }
    }
    for (int m = gw; m < MT; m += NGW) {
        const float* xrow = m < MP ? a.in[0] + (size_t)m * DM : a.in[1] + (size_t)(m - MP) * DM;
        rms_row_to_bf16(xrow, a.in[6], (bf16*)(ws + WS_XN) + (size_t)m * DM, lane);
    }
    for (int e = vcu * NTHR + tid; e < SEQ * 8; e += G * NTHR) {
        const int pos = e >> 3, j = e & 7;
        const float invf = j == 0 ? 1.0f : j == 1 ? 0.193922758102417f : j == 2 ? 0.03760603070259094f : j == 3 ? 0.00729266507551074f : j == 4 ? 0.001414213445968926f
                         : j == 5 ? 0.00027424818836152554f : j == 6 ? 5.318296462064609e-05f : 1.0313385246263351e-05f;
        const float ang = (float)pos * invf;
        const double rev = (double)ang * 0.15915494309189535; const float fr = (float)(rev - __builtin_rint(rev));
        ((float2*)(ws + WS_ROPE))[e] = make_float2(__builtin_amdgcn_cosf(fr), __builtin_amdgcn_sinf(fr));
    }
    if (vcu == 0) {
        float* scal = (float*)(ws + WS_SCAL);
        if (wave == 0) {
            const float s1 = wave_sum(a.in[9][lane] * a.in[10][lane]), s2 = wave_sum(a.in[11][lane] * a.in[12][lane]);
            if (lane == 0) scal[0] = __expf(s1) - __expf(s2) + LAM_INIT;
        }
        { const float l0 = a.in[14][tid], l1 = a.in[14][HW + tid]; scal[64 + tid] = 1.f / (1.f + __expf(l1 - l0)); }
    }
}

struct EpiInProj {
    static constexpr bool PERM = true, AFTER_DRAIN = false;
    bf16 *Q, *K, *V, *QH, *KH, *VH, *GH; float* LF; float* out; const float2* rope; const float* lb;
    __device__ __forceinline__ void operator()(const pg8::f32x4 (&acc)[2][2][4][2], const pg8::Unit& u, int wr, int wc, int fr, int fq) const {
        const int cls = u.pn >> 1, colt = (u.pn & 1) * 256;
        const int row0 = u.pm * 256 + wr * 64 + fr, col0 = colt + wc * 32 + 8 * fq;
#pragma unroll
        for (int ai = 0; ai < 2; ++ai)
#pragma unroll
            for (int m = 0; m < 4; ++m) {
                const int row = row0 + ai * 128 + m * 16;
#pragma unroll
                for (int bj = 0; bj < 2; ++bj) {
                    const int col = col0 + bj * 128;
                    float v[8];
#pragma unroll
                    for (int i = 0; i < 4; ++i) { v[i] = acc[ai][bj][m][0][i]; v[4 + i] = acc[ai][bj][m][1][i]; }
                    const size_t o512 = (size_t)row * HW + col;
                    if (cls <= 1) {
                        if ((wc & 1) == 0) {
                            float pv[8];
#pragma unroll
                            for (int i = 0; i < 8; ++i) pv[i] = __shfl_xor(v[i], 16);
                            if (fq < 2) {
                                const int pos = row < MP ? (row & (SEQ - 1)) : 2048 + ((row - MP) & 3);
                                const float2* cs = rope + pos * 8;
#pragma unroll
                                for (int i = 0; i < 8; ++i) { const float2 c = cs[i]; v[i] = fq == 0 ? v[i] * c.x - pv[i] * c.y : v[i] * c.x + pv[i] * c.y; }
                            }
                        }
                        if (cls == 0) {
                            v4u w; w.x = pk2(v[0] * QSCALE, v[1] * QSCALE); w.y = pk2(v[2] * QSCALE, v[3] * QSCALE); w.z = pk2(v[4] * QSCALE, v[5] * QSCALE); w.w = pk2(v[6] * QSCALE, v[7] * QSCALE);
                            *(v4u*)(Q + o512) = w;
                        } else {
                            v4u w; w.x = pk2(v[0], v[1]); w.y = pk2(v[2], v[3]); w.z = pk2(v[4], v[5]); w.w = pk2(v[6], v[7]);
                            *(v4u*)(K + o512) = w;
                            float* op = row < MP ? out + OKP + o512 : out + OKS + (size_t)(row - MP) * HW + col;
                            *(f32x4*)op = (f32x4){v[0], v[1], v[2], v[3]}; *(f32x4*)(op + 4) = (f32x4){v[4], v[5], v[6], v[7]};
                        }
                    } else if (cls == 2) {
                        v4u w; w.x = pk2(v[0], v[1]); w.y = pk2(v[2], v[3]); w.z = pk2(v[4], v[5]); w.w = pk2(v[6], v[7]);
                        *(v4u*)(V + o512) = w;
                        float* op = row < MP ? out + OVP + o512 : out + OVS + (size_t)(row - MP) * HW + col;
                        *(f32x4*)op = (f32x4){v[0], v[1], v[2], v[3]}; *(f32x4*)(op + 4) = (f32x4){v[4], v[5], v[6], v[7]};
                    } else if (cls == 3 || cls == 6) {
#pragma unroll
                        for (int i = 0; i < 8; ++i) v[i] = v[i] * sigmoidf_(v[i]);
                        v4u w; w.x = pk2(v[0], v[1]); w.y = pk2(v[2], v[3]); w.z = pk2(v[4], v[5]); w.w = pk2(v[6], v[7]);
                        *(v4u*)((cls == 3 ? QH : GH) + o512) = w;
                    } else if (cls == 4) {
                        const f32x4 l0 = *(const f32x4*)(lb + col), l1 = *(const f32x4*)(lb + col + 4);
                        float lg[8], kk[8];
#pragma unroll
                        for (int i = 0; i < 8; ++i) { const float lbv = i < 4 ? l0[i] : l1[i - 4]; const float f = lbv + (1.f - lbv) * sigmoidf_(v[i]); lg[i] = __logf(f); kk[i] = 1.f - f; }
                        *(f32x4*)(LF + o512) = (f32x4){lg[0], lg[1], lg[2], lg[3]}; *(f32x4*)(LF + o512 + 4) = (f32x4){lg[4], lg[5], lg[6], lg[7]};
                        v4u w; w.x = pk2(kk[0], kk[1]); w.y = pk2(kk[2], kk[3]); w.z = pk2(kk[4], kk[5]); w.w = pk2(kk[6], kk[7]);
                        *(v4u*)(KH + o512) = w;
                    } else {
                        v4u w; w.x = pk2(v[0], v[1]); w.y = pk2(v[2], v[3]); w.z = pk2(v[4], v[5]); w.w = pk2(v[6], v[7]);
                        *(v4u*)(VH + o512) = w;
                    }
                }
            }
    }
};
struct EpiResF32 {
    static constexpr bool PERM = false, AFTER_DRAIN = false;
    const float* basep; const float* bases; float* out;
    __device__ __forceinline__ void operator()(const pg8::f32x4 (&acc)[2][2][4][2], const pg8::Unit& u, int wr, int wc, int fr, int fq) const {
        const int col0 = u.pn * 256 + wc * 32 + 4 * fq;
#pragma unroll
        for (int ai = 0; ai < 2; ++ai)
#pragma unroll
            for (int m = 0; m < 4; ++m) {
                const int row = u.pm * 256 + ai * 128 + wr * 64 + m * 16 + fr;
                const float* bp = row < MP ? basep + (size_t)row * DM : bases + (size_t)(row - MP) * DM;
                float* op = out + (size_t)row * DM;
#pragma unroll
                for (int bj = 0; bj < 2; ++bj)
#pragma unroll
                    for (int n = 0; n < 2; ++n) { const int col = col0 + bj * 128 + n * 16; *(f32x4*)(op + col) = *(const f32x4*)(bp + col) + acc[ai][bj][m][n]; }
            }
    }
};
struct EpiSwiGLU {
    static constexpr bool PERM = true, AFTER_DRAIN = false;
    bf16* ACT;
    __device__ __forceinline__ void operator()(const pg8::f32x4 (&acc)[2][2][4][2], const pg8::Unit& u, int wr, int wc, int fr, int fq) const {
        const int col0 = u.pn * 128 + wc * 32 + 8 * fq;
#pragma unroll
        for (int ai = 0; ai < 2; ++ai)
#pragma unroll
            for (int m = 0; m < 4; ++m) {
                const int row = u.pm * 256 + ai * 128 + wr * 64 + m * 16 + fr;
                float v[8];
#pragma unroll
                for (int i = 0; i < 4; ++i) { const float g0 = acc[ai][0][m][0][i], g1 = acc[ai][0][m][1][i]; v[i] = g0 * sigmoidf_(g0) * acc[ai][1][m][0][i]; v[4 + i] = g1 * sigmoidf_(g1) * acc[ai][1][m][1][i]; }
                v4u w; w.x = pk2(v[0], v[1]); w.y = pk2(v[2], v[3]); w.z = pk2(v[4], v[5]); w.w = pk2(v[6], v[7]);
                *(v4u*)(ACT + (size_t)row * DFF + col0) = w;
            }
    }
};

__device__ __forceinline__ void hgrn_cumsum(const float* LF, int row0, int hcol, LAS float* tot, int tid, float (&b)[16], float& r31, float& blast) {
    const int k = tid & 127, tq = tid >> 7;
    const float* p = LF + (size_t)(row0 + 16 * tq) * HW + hcol + k;
    float c = 0.f;
#pragma unroll
    for (int i = 0; i < 16; ++i) { c += p[(size_t)i * HW]; b[i] = c; }
    tot[tq * 128 + k] = c;
    __syncthreads();
    const float t0 = tot[k], t1 = tot[128 + k], t2 = tot[256 + k], t3 = tot[384 + k];
    const float off = tq == 0 ? 0.f : tq == 1 ? t0 : tq == 2 ? t0 + t1 : (t0 + t1) + t2;
#pragma unroll
    for (int i = 0; i < 16; ++i) b[i] += off;
    r31 = t0 + t1; blast = (t0 + t1) + (t2 + t3);
}
constexpr int HL_TOT = 0, HL_VT = 2048, HL_KT = 20480, HL_QT = 20480, HL_QH = 37888, HL_KK = 55296, HL_AM = 72704, HL_SSQ = 81920;
__device__ __forceinline__ void hgrn_stage_vt(const bf16* VH, int row0, int hcol, LAS unsigned char* VT, int tid) {
    const int v = tid & 127, tq = tid >> 7;
    const bf16* vp = VH + (size_t)(row0 + 16 * tq) * HW + hcol + v;
    unsigned vw[8];
#pragma unroll
    for (int i = 0; i < 8; ++i) vw[i] = (unsigned)vp[(size_t)(2 * i) * HW] | ((unsigned)vp[(size_t)(2 * i + 1) * HW] << 16);
    *(LAS v4u*)(VT + v * 144 + tq * 32) = (v4u){vw[0], vw[1], vw[2], vw[3]};
    *(LAS v4u*)(VT + v * 144 + tq * 32 + 16) = (v4u){vw[4], vw[5], vw[6], vw[7]};
}
__device__ __forceinline__ void hgrn_a_item(int it, const float* LF, const bf16* KH, const bf16* VH, bf16* HU, float* HD, LAS unsigned char* lds, int tid, int lane, int wave) {
    const int bh = it >> 7, c = it & 127, b = bh >> 2, h = bh & 3, row0 = b * SEQ + c * 64, hcol = h * 128;
    LAS float* tot = (LAS float*)(lds + HL_TOT); LAS unsigned char* KT = lds + HL_KT; LAS unsigned char* VT = lds + HL_VT;
    float bb[16], r31, blast;
    hgrn_cumsum(LF, row0, hcol, tot, tid, bb, r31, blast);
    const int k = tid & 127, tq = tid >> 7;
    const bf16* kp = KH + (size_t)(row0 + 16 * tq) * HW + hcol + k;
    unsigned kw[8];
#pragma unroll
    for (int i = 0; i < 8; ++i) { const float k0 = bf2f(kp[(size_t)(2 * i) * HW]) * __expf(blast - bb[2 * i]), k1 = bf2f(kp[(size_t)(2 * i + 1) * HW]) * __expf(blast - bb[2 * i + 1]); kw[i] = pk2(k0, k1); }
    *(LAS v4u*)(KT + k * 144 + tq * 32) = (v4u){kw[0], kw[1], kw[2], kw[3]};
    *(LAS v4u*)(KT + k * 144 + tq * 32 + 16) = (v4u){kw[4], kw[5], kw[6], kw[7]};
    hgrn_stage_vt(VH, row0, hcol, VT, tid);
    if (tq == 0) HD[(size_t)(bh * 128 + c) * 128 + k] = __expf(blast);
    __syncthreads();
    const int l15 = lane & 15, quad = lane >> 4;
    const bf16x8 a0 = *(const LAS bf16x8*)(KT + (16 * wave + l15) * 144 + quad * 16), a1 = *(const LAS bf16x8*)(KT + (16 * wave + l15) * 144 + 64 + quad * 16);
#pragma unroll
    for (int nb = 0; nb < 8; ++nb) {
        const bf16x8 b0 = *(const LAS bf16x8*)(VT + (16 * nb + l15) * 144 + quad * 16), b1 = *(const LAS bf16x8*)(VT + (16 * nb + l15) * 144 + 64 + quad * 16);
        f32x4 acc = (f32x4){0.f, 0.f, 0.f, 0.f};
        acc = mfma16(a0, b0, acc); acc = mfma16(a1, b1, acc);
        *(u32x2*)(HU + ((size_t)(bh * 128 + c) * 128 + 16 * nb + l15) * 128 + 16 * wave + 4 * quad) = (u32x2){pk2(acc[0], acc[1]), pk2(acc[2], acc[3])};
    }
    __syncthreads();
}
__device__ __forceinline__ void hgrn_b_scan(const bf16* HU, const float* HD, bf16* HS, float* sout, int vcu, int G, int tid) {
    for (int e = vcu * NTHR + tid; e < 8 * 16384; e += G * NTHR) {
        const int bh = e >> 14, v = (e >> 7) & 127, k = e & 127;
        const size_t base = (size_t)bh * 128 * 16384 + (size_t)v * 128 + k;
        const float* dp = HD + (size_t)bh * 128 * 128 + k;
        float S = 0.f;
#pragma unroll 8
        for (int c = 0; c < 128; ++c) {
            const float u = bf2f(HU[base + (size_t)c * 16384]), d = dp[c * 128];
            HS[base + (size_t)c * 16384] = (bf16)f2bf(S);
            S = d * S + u;
        }
        sout[((size_t)bh * 128 + k) * 128 + v] = S;
    }
}
__device__ __forceinline__ void hgrn_c_item(int it, const float* LF, const bf16* QH, const bf16* KH, const bf16* VH, const bf16* GH, const bf16* HS, const float* hnorm, bf16* MIX,
                                            LAS unsigned char* lds, int tid, int lane, int wave) {
    const int b = it >> 7, c = it & 127, row0 = b * SEQ + c * 64;
    LAS float* tot = (LAS float*)(lds + HL_TOT); LAS unsigned char* VT = lds + HL_VT; LAS unsigned char* QT = lds + HL_QT; LAS unsigned char* QHt = lds + HL_QH;
    LAS unsigned char* KK = lds + HL_KK; LAS unsigned char* AM = lds + HL_AM; LAS float* SSQ = (LAS float*)(lds + HL_SSQ);
    const int l15 = lane & 15, quad = lane >> 4;
    f32x4 oacc[4][4];
#pragma unroll
    for (int h = 0; h < 4; ++h) {
        const int bh = b * 4 + h, hcol = h * 128;
        float bb[16], r31, blast;
        hgrn_cumsum(LF, row0, hcol, tot, tid, bb, r31, blast);
        const int k = tid & 127, tq = tid >> 7;
        const bf16* qp = QH + (size_t)(row0 + 16 * tq) * HW + hcol + k; const bf16* kp = KH + (size_t)(row0 + 16 * tq) * HW + hcol + k;
#pragma unroll
        for (int i = 0; i < 16; ++i) {
            const int t = 16 * tq + i; const float q = bf2f(qp[(size_t)i * HW]), kk = bf2f(kp[(size_t)i * HW]);
            *(LAS bf16*)(QT + t * 272 + k * 2) = (bf16)f2bf(q * __expf(bb[i] - r31));
            *(LAS bf16*)(QHt + t * 272 + k * 2) = (bf16)f2bf(q * __expf(bb[i]));
            *(LAS bf16*)(KK + t * 272 + k * 2) = (bf16)f2bf(kk * __expf(r31 - bb[i]));
        }
        hgrn_stage_vt(VH, row0, hcol, VT, tid);
        __syncthreads();
        {
            const int tb = wave >> 1;
#pragma unroll
            for (int e = 0; e < 2; ++e) {
                const int sb = 2 * (wave & 1) + e;
                f32x4 acc = (f32x4){0.f, 0.f, 0.f, 0.f};
                if (sb <= tb) {
#pragma unroll
                    for (int ks = 0; ks < 4; ++ks) {
                        const bf16x8 af = *(const LAS bf16x8*)(KK + (16 * sb + l15) * 272 + ks * 64 + quad * 16);
                        const bf16x8 bq = *(const LAS bf16x8*)(QT + (16 * tb + l15) * 272 + ks * 64 + quad * 16);
                        acc = mfma16(af, bq, acc);
                    }
                    const int t = 16 * tb + l15, s0 = 16 * sb + 4 * quad;
#pragma unroll
                    for (int j = 0; j < 4; ++j) if (s0 + j > t) acc[j] = 0.f;
                }
                *(LAS u32x2*)(AM + (16 * tb + l15) * 144 + (16 * sb + 4 * quad) * 2) = (u32x2){pk2(acc[0], acc[1]), pk2(acc[2], acc[3])};
            }
        }
        __syncthreads();
        {
            bf16x8 av[2], as[4];
#pragma unroll
            for (int ks = 0; ks < 2; ++ks) av[ks] = *(const LAS bf16x8*)(VT + (16 * wave + l15) * 144 + ks * 64 + quad * 16);
            const bf16* sp = HS + ((size_t)(bh * 128 + c) * 128 + 16 * wave + l15) * 128 + 8 * quad;
#pragma unroll
            for (int ks = 0; ks < 4; ++ks) as[ks] = *(const bf16x8*)(sp + 32 * ks);
#pragma unroll
            for (int tb = 0; tb < 4; ++tb) {
                f32x4 acc = (f32x4){0.f, 0.f, 0.f, 0.f};
#pragma unroll
                for (int ks = 0; ks < 2; ++ks) acc = mfma16(av[ks], *(const LAS bf16x8*)(AM + (16 * tb + l15) * 144 + ks * 64 + quad * 16), acc);
#pragma unroll
                for (int ks = 0; ks < 4; ++ks) acc = mfma16(as[ks], *(const LAS bf16x8*)(QHt + (16 * tb + l15) * 272 + ks * 64 + quad * 16), acc);
                oacc[h][tb] = acc;
            }
        }
        __syncthreads();
    }
#pragma unroll
    for (int tb = 0; tb < 4; ++tb) {
        float s = 0.f;
#pragma unroll
        for (int h = 0; h < 4; ++h)
#pragma unroll
            for (int j = 0; j < 4; ++j) s += oacc[h][tb][j] * oacc[h][tb][j];
        s += __shfl_xor(s, 16); s += __shfl_xor(s, 32);
        if (quad == 0) SSQ[wave * 64 + 16 * tb + l15] = s;
    }
    __syncthreads();
#pragma unroll
    for (int tb = 0; tb < 4; ++tb) {
        const int t = 16 * tb + l15; float ss = 0.f;
#pragma unroll
        for (int w = 0; w < 8; ++w) ss += SSQ[w * 64 + t];
        const float rstd = 1.f / sqrtf(ss * (1.f / HW) + RMS_EPS);
        const size_t row = (size_t)(row0 + t);
#pragma unroll
        for (int h = 0; h < 4; ++h) {
            const int col = h * 128 + 16 * wave + 4 * quad;
            const u32x2 g = *(const u32x2*)(GH + row * HW + col); const f32x4 wn = *(const f32x4*)(hnorm + col);
            const float v0 = oacc[h][tb][0] * rstd * wn[0] * __uint_as_float(g.x << 16), v1 = oacc[h][tb][1] * rstd * wn[1] * __uint_as_float(g.x & 0xffff0000u);
            const float v2 = oacc[h][tb][2] * rstd * wn[2] * __uint_as_float(g.y << 16), v3 = oacc[h][tb][3] * rstd * wn[3] * __uint_as_float(g.y & 0xffff0000u);
            *(u32x2*)(MIX + row * DM + HW + col) = (u32x2){pk2(v0, v1), pk2(v2, v3)};
        }
    }
    __syncthreads();
}
__device__ __forceinline__ void hgrn_dec_item(int it, const float* LF, const bf16* QH, const bf16* KH, const bf16* VH, const float* state, float* sout, float* OHS, LAS unsigned char* lds, int tid) {
    const int bd = it >> 2, h = it & 3, row0 = MP + bd * 4, hcol = h * 128;
    LAS float* F = (LAS float*)lds; LAS float* KKs = F + 512; LAS float* QQ = F + 1024; LAS float* OP = F + 1536;
    { const int t = tid >> 7, k = tid & 127; const size_t o = (size_t)(row0 + t) * HW + hcol + k; F[tid] = __expf(LF[o]); KKs[tid] = bf2f(KH[o]); QQ[tid] = bf2f(QH[o]); }
    __syncthreads();
    const int v = tid & 127, kg = tid >> 7;
    const size_t sbase = ((size_t)(bd * 4 + h) * 128 + 32 * kg) * 128 + v;
    float S[32];
#pragma unroll
    for (int i = 0; i < 32; ++i) S[i] = state[sbase + (size_t)i * 128];
#pragma unroll
    for (int t = 0; t < 4; ++t) {
        const float vv = bf2f(VH[(size_t)(row0 + t) * HW + hcol + v]); float op = 0.f;
#pragma unroll
        for (int i = 0; i < 32; ++i) { const int ki = t * 128 + 32 * kg + i; S[i] = F[ki] * S[i] + KKs[ki] * vv; op += S[i] * QQ[ki]; }
        OP[(kg * 4 + t) * 128 + v] = op;
    }
#pragma unroll
    for (int i = 0; i < 32; ++i) sout[sbase + (size_t)i * 128] = S[i];
    __syncthreads();
    { const int t = tid >> 7, vv = tid & 127; OHS[(size_t)(bd * 4 + t) * HW + hcol + vv] = (OP[(0 * 4 + t) * 128 + vv] + OP[(1 * 4 + t) * 128 + vv]) + (OP[(2 * 4 + t) * 128 + vv] + OP[(3 * 4 + t) * 128 + vv]); }
    __syncthreads();
}

__device__ __forceinline__ void mix_attn_row(const bf16* O16, float lam, const float* subw, bf16* MIX, size_t row, int lane) {
    const float w0 = subw[2 * lane] * ONE_MINUS_LAM_INIT, w1 = subw[2 * lane + 1] * ONE_MINUS_LAM_INIT;
#pragma unroll
    for (int h = 0; h < 4; ++h) {
        const unsigned a = *(const unsigned*)(O16 + row * DM + h * 256 + 2 * lane), b = *(const unsigned*)(O16 + row * DM + h * 256 + 128 + 2 * lane);
        const float d0 = __uint_as_float(a << 16) - lam * __uint_as_float(b << 16), d1 = __uint_as_float(a & 0xffff0000u) - lam * __uint_as_float(b & 0xffff0000u);
        const float rstd = 1.f / sqrtf(wave_sum(d0 * d0 + d1 * d1) * (1.f / 128.f) + SUBLN_EPS);
        *(unsigned*)(MIX + row * DM + h * 128 + 2 * lane) = pk2(d0 * rstd * w0, d1 * rstd * w1);
    }
}
__device__ __forceinline__ void mix_hgrn_row(const float* OHS, const bf16* GH, const float* hnorm, bf16* MIX, int srow, int lane) {
    const f32x4 x0 = *(const f32x4*)(OHS + (size_t)srow * HW + 4 * lane), x1 = *(const f32x4*)(OHS + (size_t)srow * HW + 256 + 4 * lane);
    const float ss = wave_sum((x0.x * x0.x + x0.y * x0.y) + (x0.z * x0.z + x0.w * x0.w) + (x1.x * x1.x + x1.y * x1.y) + (x1.z * x1.z + x1.w * x1.w));
    const float rstd = 1.f / sqrtf(ss * (1.f / HW) + RMS_EPS);
    const size_t row = (size_t)(MP + srow);
#pragma unroll
    for (int p = 0; p < 2; ++p) {
        const f32x4 x = p == 0 ? x0 : x1; const int col = 256 * p + 4 * lane;
        const u32x2 g = *(const u32x2*)(GH + row * HW + col); const f32x4 wn = *(const f32x4*)(hnorm + col);
        const float v0 = x.x * rstd * wn[0] * __uint_as_float(g.x << 16), v1 = x.y * rstd * wn[1] * __uint_as_float(g.x & 0xffff0000u);
        const float v2 = x.z * rstd * wn[2] * __uint_as_float(g.y << 16), v3 = x.w * rstd * wn[3] * __uint_as_float(g.y & 0xffff0000u);
        *(u32x2*)(MIX + row * DM + HW + col) = (u32x2){pk2(v0, v1), pk2(v2, v3)};
    }
}
__device__ __forceinline__ void rms_row_inplace(float* xrow, const float* gain, int lane) {
    GAS f32x4* xr = (GAS f32x4*)xrow + lane; const GAS f32x4* gr = (const GAS f32x4*)gain + lane;
    f32x4 v[4]; float s = 0.f;
#pragma unroll
    for (int j = 0; j < 4; ++j) { v[j] = xr[64 * j]; s += (v[j].x * v[j].x + v[j].y * v[j].y) + (v[j].z * v[j].z + v[j].w * v[j].w); }
    const float rstd = 1.f / sqrtf(wave_sum(s) * (1.f / DM) + RMS_EPS);
#pragma unroll
    for (int j = 0; j < 4; ++j) { const f32x4 g = gr[64 * j]; xr[64 * j] = (f32x4){v[j].x * rstd * g.x, v[j].y * rstd * g.y, v[j].z * rstd * g.z, v[j].w * rstd * g.w}; }
}
namespace dec {
using bf16x2v = __attribute__((ext_vector_type(2))) __bf16;
using f32x8 = __attribute__((ext_vector_type(8))) float;
using u32x4 = __attribute__((ext_vector_type(4))) unsigned;
constexpr int WAVES = 8, GEP = 8, HPL = 2, PPW = 16, TOKS = 512;
constexpr int LDS_P = 0, LDS_MRG = WAVES * 64 * HPL, MRG_REC = 4 + 128, LDS_OUT = LDS_MRG + WAVES * GEP * MRG_REC, LDS_FLOATS = LDS_OUT + 8 * 128;
__device__ __forceinline__ float dot2(unsigned k, unsigned q, float acc) { return __builtin_amdgcn_fdot2_f32_bf16(__builtin_bit_cast(bf16x2v, k), __builtin_bit_cast(bf16x2v, q), acc, false); }
__device__ __forceinline__ unsigned cvtpk(float lo, float hi) { unsigned r; asm volatile("v_cvt_pk_bf16_f32 %0, %1, %2" : "=v"(r) : "v"(lo), "v"(hi)); return r; }
template <int CTRL> __device__ __forceinline__ float dpp(float x) { return __builtin_bit_cast(float, __builtin_amdgcn_mov_dpp(__builtin_bit_cast(int, x), CTRL, 0xf, 0xf, true)); }
constexpr int XOR1 = 0xB1, XOR2 = 0x4E, XOR7 = 0x141, XOR8 = 0x128, ROR4 = 0x124;
__device__ __forceinline__ float xrow16_max(float x) {
    auto s = __builtin_amdgcn_permlane16_swap(__float_as_uint(x), __float_as_uint(x), false, false);
    x = fmaxf(__uint_as_float(s[0]), __uint_as_float(s[1]));
    auto t = __builtin_amdgcn_permlane32_swap(__float_as_uint(x), __float_as_uint(x), false, false);
    return fmaxf(__uint_as_float(t[0]), __uint_as_float(t[1]));
}
__device__ __forceinline__ float xrow16_sum(float x) {
    auto s = __builtin_amdgcn_permlane16_swap(__float_as_uint(x), __float_as_uint(x), false, false);
    x = __uint_as_float(s[0]) + __uint_as_float(s[1]);
    auto t = __builtin_amdgcn_permlane32_swap(__float_as_uint(x), __float_as_uint(x), false, false);
    return __uint_as_float(t[0]) + __uint_as_float(t[1]);
}
__device__ __forceinline__ u32x4 tobf(f32x8 x) { u32x4 w = {cvtpk(x[0], x[1]), cvtpk(x[2], x[3]), cvtpk(x[4], x[5]), cvtpk(x[6], x[7])}; return w; }
__device__ __forceinline__ f32x8 ld8nt(const float* p) { return __builtin_nontemporal_load(reinterpret_cast<const f32x8*>(p)); }

__device__ __forceinline__ void decode_attn_item(int it, const unsigned short* Qb, const unsigned short* Kb, const unsigned short* Vb, const float* ck, const float* cv, const int* pt,
                                                 float lam, const float* subw, unsigned short* MIX, LAS float* lds, int tid, int lane, int wave) {
    const int bd = it >> 2, h = it & 3, r = lane >> 4, c = lane & 15;
    const size_t qrow0 = (size_t)(MP + bd * 4);
    int btv = 0; if (lane < 16) btv = pt[bd * 16 + lane];
    u32x4 qsh[4];
#pragma unroll
    for (int qi = 0; qi < 4; ++qi) qsh[qi] = *reinterpret_cast<const u32x4*>(Qb + (qrow0 + qi) * 512 + h * 128 + 8 * c);
    const bool map1 = c >= 8;
    const size_t loff = (size_t)(wave * 16 + r) * TOKS + h * 128 + 8 * c;
#define DEC_ISSUE_K(i_) do { const int phys_ = __builtin_amdgcn_readlane(btv, (i_)); const float* kb_ = ck + (size_t)phys_ * (128 * TOKS) + loff; \
    _Pragma("unroll") for (int t_ = 0; t_ < 4; ++t_) Kn[t_] = ld8nt(kb_ + (size_t)t_ * 4 * TOKS); } while (0)
#define DEC_ISSUE_V(i_) do { const int phys_ = __builtin_amdgcn_readlane(btv, (i_)); const float* vb_ = cv + (size_t)phys_ * (128 * TOKS) + loff; \
    _Pragma("unroll") for (int t_ = 0; t_ < 4; ++t_) Vn[t_] = ld8nt(vb_ + (size_t)t_ * 4 * TOKS); } while (0)
    f32x8 Kn[4], Vn[4];
    float m[HPL], l[HPL], acc[GEP * 8];
#pragma unroll
    for (int j = 0; j < HPL; ++j) { m[j] = -INFINITY; l[j] = 0.f; }
#pragma unroll
    for (int k = 0; k < GEP * 8; ++k) acc[k] = 0.f;
    DEC_ISSUE_K(0); DEC_ISSUE_V(0);
    for (int i = 0; i < PPW; ++i) {
        float x[4 * GEP];
        {
            u32x4 Kc[4];
#pragma unroll
            for (int t = 0; t < 4; ++t) Kc[t] = tobf(Kn[t]);
            if (i + 1 < PPW) DEC_ISSUE_K(i + 1);
#pragma unroll
            for (int t = 0; t < 4; ++t)
#pragma unroll
                for (int qi = 0; qi < 4; ++qi) { float d = 0.f;
#pragma unroll
                    for (int k = 0; k < 4; ++k) d = dot2(Kc[t][k], qsh[qi][k], d);
                    x[t * GEP + qi] = map1 ? 0.f : d; x[t * GEP + 4 + qi] = map1 ? d : 0.f; }
        }
#define DEC_TR_STEP(HALF, CTRL, BIT) _Pragma("unroll") for (int hh = 0; hh < (HALF); ++hh) _Pragma("unroll") for (int j = 0; j < HPL; ++j) { \
      const float lo_ = x[hh * HPL + j], hi_ = x[(hh + (HALF)) * HPL + j]; const float t1_ = lo_ + dpp<CTRL>(lo_), t2_ = hi_ + dpp<CTRL>(hi_); \
      x[hh * HPL + j] = (c & (BIT)) ? t2_ : t1_; }
        DEC_TR_STEP(8, XOR8, 8) DEC_TR_STEP(4, XOR7, 4) DEC_TR_STEP(2, XOR2, 2) DEC_TR_STEP(1, XOR1, 1)
#undef DEC_TR_STEP
        float p[HPL], alpha[HPL];
#pragma unroll
        for (int j = 0; j < HPL; ++j) {
            const float sc = x[j];
            float pm = sc; pm = fmaxf(pm, dpp<ROR4>(pm)); pm = fmaxf(pm, dpp<XOR8>(pm)); pm = xrow16_max(pm);
            const float mn = fmaxf(m[j], pm);
            alpha[j] = __builtin_amdgcn_exp2f(m[j] - mn); p[j] = __builtin_amdgcn_exp2f(sc - mn);
            l[j] = fmaf(l[j], alpha[j], p[j]); m[j] = mn;
        }
#pragma unroll
        for (int q4 = 0; q4 < 4; ++q4)
#pragma unroll
            for (int j = 0; j < HPL; ++j) {
                const float al = q4 == 0 ? dpp<0x00>(alpha[j]) : q4 == 1 ? dpp<0x55>(alpha[j]) : q4 == 2 ? dpp<0xAA>(alpha[j]) : dpp<0xFF>(alpha[j]);
#pragma unroll
                for (int k = 0; k < 8; ++k) acc[(q4 * HPL + j) * 8 + k] *= al; }
        LAS float* prow = lds + LDS_P + (wave * 4 + r) * 16 * HPL;
#pragma unroll
        for (int j = 0; j < HPL; ++j) prow[c * HPL + j] = p[j];
        asm volatile("s_waitcnt lgkmcnt(0)" ::: "memory");
        u32x4 Vc[4];
#pragma unroll
        for (int t = 0; t < 4; ++t) Vc[t] = tobf(Vn[t]);
        if (i + 1 < PPW) DEC_ISSUE_V(i + 1);
        f32x4 pr[GEP];
#pragma unroll
        for (int u = 0; u < GEP; ++u) pr[u] = *(const LAS f32x4*)(prow + 4 * u);
#pragma unroll
        for (int t = 0; t < 4; ++t) {
            float vf[8];
#pragma unroll
            for (int k = 0; k < 4; ++k) { vf[2 * k] = __builtin_bit_cast(float, Vc[t][k] << 16); vf[2 * k + 1] = __builtin_bit_cast(float, Vc[t][k] & 0xffff0000u); }
#pragma unroll
            for (int g = 0; g < GEP; ++g) { const float pg_ = pr[(t * GEP + g) >> 2][(t * GEP + g) & 3];
#pragma unroll
                for (int k = 0; k < 8; ++k) acc[g * 8 + k] = fmaf(pg_, vf[k], acc[g * 8 + k]); } }
        asm volatile("s_waitcnt lgkmcnt(0)" ::: "memory");
    }
#undef DEC_ISSUE_K
#undef DEC_ISSUE_V
#pragma unroll
    for (int k = 0; k < GEP * 8; ++k) acc[k] = xrow16_sum(acc[k]);
#pragma unroll
    for (int j = 0; j < HPL; ++j) { float t = l[j]; t += dpp<ROR4>(t); t += dpp<XOR8>(t); l[j] = xrow16_sum(t); }
    LAS float* mrg = lds + LDS_MRG;
    if (r == 0) {
#pragma unroll
        for (int g = 0; g < GEP; ++g) {
            LAS float* rec = mrg + (wave * GEP + g) * MRG_REC;
#pragma unroll
            for (int k = 0; k < 8; k += 4) *(LAS f32x4*)(rec + 4 + 8 * c + k) = f32x4{acc[g * 8 + k], acc[g * 8 + k + 1], acc[g * 8 + k + 2], acc[g * 8 + k + 3]};
            if (c == g / HPL) { rec[0] = m[g % HPL]; rec[1] = l[g % HPL]; } } }
    __syncthreads();
    {
        const int g = wave, map = g >> 2, qi = g & 3, d0 = 2 * lane;
        const float qv = bf2f(Qb[(qrow0 + qi) * 512 + h * 128 + map * 64 + lane]);
        float sn[4];
#pragma unroll
        for (int j = 0; j < 4; ++j) sn[j] = wave_sum(qv * bf2f(Kb[(qrow0 + j) * 512 + h * 128 + map * 64 + lane]));
        float M = -INFINITY;
#pragma unroll
        for (int w = 0; w < WAVES; ++w) M = fmaxf(M, mrg[(w * GEP + g) * MRG_REC]);
#pragma unroll
        for (int j = 0; j < 4; ++j) if (j <= qi) M = fmaxf(M, sn[j]);
        float L = 0.f, o0 = 0.f, o1 = 0.f;
#pragma unroll
        for (int w = 0; w < WAVES; ++w) { const LAS float* rec = mrg + (w * GEP + g) * MRG_REC; const float lw = rec[1];
            const float wt = __builtin_amdgcn_exp2f(rec[0] - M);
            L = fmaf(wt, lw, L); o0 = fmaf(wt, rec[4 + d0], o0); o1 = fmaf(wt, rec[4 + d0 + 1], o1); }
#pragma unroll
        for (int j = 0; j < 4; ++j) if (j <= qi) {
            const float pj = __builtin_amdgcn_exp2f(sn[j] - M);
            const unsigned vw = *reinterpret_cast<const unsigned*>(Vb + (qrow0 + j) * 512 + h * 128 + d0);
            L += pj; o0 = fmaf(pj, __uint_as_float(vw << 16), o0); o1 = fmaf(pj, __uint_as_float(vw & 0xffff0000u), o1); }
        const float inv = 1.f / L;
        lds[LDS_OUT + g * 128 + d0] = o0 * inv; lds[LDS_OUT + g * 128 + d0 + 1] = o1 * inv;
    }
    __syncthreads();
    if (wave < 4) {
        const int qi = wave, d0 = 2 * lane;
        const float a0 = lds[LDS_OUT + qi * 128 + d0] - lam * lds[LDS_OUT + (4 + qi) * 128 + d0], a1 = lds[LDS_OUT + qi * 128 + d0 + 1] - lam * lds[LDS_OUT + (4 + qi) * 128 + d0 + 1];
        const float rstd = 1.f / sqrtf(wave_sum(a0 * a0 + a1 * a1) * (1.f / 128.f) + SUBLN_EPS);
        *reinterpret_cast<unsigned*>(MIX + (qrow0 + qi) * DM + h * 128 + d0) = pk2(a0 * rstd * subw[d0] * ONE_MINUS_LAM_INIT, a1 * rstd * subw[d0 + 1] * ONE_MINUS_LAM_INIT);
    }
    __syncthreads();
}
}
#ifndef PH
#define PH 0xFFFF
#endif
struct AttnOrder {
    int vcu, G;
    __device__ __forceinline__ bool next(int i, attn_body::AttnUnit& u) const {
        const int slot = vcu + (i >> 2) * G; if (slot >= 256) return false;
        const int s = slot & 7, k = i & 3; u.bh = slot >> 3; u.qb = (k == 0) ? s : (k == 1) ? 15 - s : (k == 2) ? 16 + s : 31 - s; return true; }
    __device__ __forceinline__ void a_ready(const attn_body::AttnUnit&) const {}
    __device__ __forceinline__ void done(const attn_body::AttnUnit&) const {}
};

__device__ __forceinline__ const unsigned long long* karg() {
    const unsigned long long __attribute__((address_space(4)))* p = (const unsigned long long __attribute__((address_space(4)))*)__builtin_amdgcn_kernarg_segment_ptr();
    asm volatile("" : "+s"(p)); return (const unsigned long long*)p; }
#define ARG_IN(i) ((const float*)karg()[(i)])
#define ARG_OUT ((float*)karg()[21])
#define ARG_WS ((unsigned char*)karg()[22])

__global__ void __launch_bounds__(NTHR, 2) hybrid_fwd(Args args) {
    extern __shared__ __attribute__((aligned(16))) unsigned char lds_raw[];
    LAS unsigned char* lds = (LAS unsigned char*)lds_raw;
    volatile LAS unsigned* MISC = (volatile LAS unsigned*)(lds + MISC_OFF);
    const int G = gridDim.x, bx = blockIdx.x, vcu = (G % 8 == 0) ? (bx % 8) * (G / 8) + bx / 8 : bx;
    const int NGW = G * NWAVES;
#define PHASE_IDS() const int tid = opaque_tid(), lane = tid & 63, wave = __builtin_amdgcn_readfirstlane(tid >> 6), gw = vcu * NWAVES + wave; (void)lane; (void)gw
    for (int u = threadIdx.x; u < (LDS_BYTES - LDSCTL_OFF) / 4; u += NTHR) ((LAS unsigned*)(lds + LDSCTL_OFF))[u] = 0u;
    __syncthreads();
    XcdBarrier bar = xcd_barrier_post((unsigned*)((gu32*)(args.ws + WS_CTL) + CW_BAR), MISC + 8);

    if (PH & 1) { PHASE_IDS(); p0_prologue(args, lds, vcu, G, tid, lane, wave); }
    xcd_barrier(bar);

    if (PH & 2) {
        unsigned char* ws = ARG_WS;
        pg8::Gemm g{(bf16*)(ws + WS_XN), (bf16*)(ws + WS_WIN), MT, NIN, DM}; pg8::StaticOrder S; S.init(MT, NIN, G, bx);
        EpiInProj E{(bf16*)(ws + WS_Q), (bf16*)(ws + WS_K), (bf16*)(ws + WS_V), (bf16*)(ws + WS_QH), (bf16*)(ws + WS_KH), (bf16*)(ws + WS_VH), (bf16*)(ws + WS_GH), (float*)(ws + WS_LF), ARG_OUT,
                    (const float2*)(ws + WS_ROPE), (const float*)(ws + WS_SCAL) + 64};
        pg8::gemm_phase<EpiInProj, pg8::StaticOrder, PG8_ALIGN, PG8_SP2>(lds + RING_OFF, g, S, E);
    }
    xcd_barrier(bar);

    if (PH & 4) { PHASE_IDS(); unsigned char* ws = ARG_WS;
        for (int it = vcu; it < 1024; it += G) hgrn_a_item(it, (const float*)(ws + WS_LF), (const bf16*)(ws + WS_KH), (const bf16*)(ws + WS_VH), (bf16*)(ws + WS_HU), (float*)(ws + WS_HD), lds, tid, lane, wave); }
    if (PH & 8) { PHASE_IDS(); unsigned char* ws = ARG_WS; const float* st = ARG_IN(4); float* out = ARG_OUT;
        for (int it = vcu; it < 512; it += G) hgrn_dec_item(it, (const float*)(ws + WS_LF), (const bf16*)(ws + WS_QH), (const bf16*)(ws + WS_KH), (const bf16*)(ws + WS_VH), st, out + OSS, (float*)(ws + WS_OHS), lds, tid); }
    xcd_barrier(bar);

    if (PH & 16) { PHASE_IDS(); unsigned char* ws = ARG_WS; hgrn_b_scan((const bf16*)(ws + WS_HU), (const float*)(ws + WS_HD), (bf16*)(ws + WS_HS), ARG_OUT + OSP, vcu, G, tid); }
    if (PH & 32) {
        unsigned char* ws = ARG_WS;
        const attn_body::AttnTensors AT{(const attn_body::bf16*)(ws + WS_Q), (const attn_body::bf16*)(ws + WS_K), (const attn_body::bf16*)(ws + WS_V), (attn_body::bf16*)(ws + WS_O16)};
        const AttnOrder S{vcu, G};
        attn_body::attn_phase<AttnOrder>((char*)lds_raw + RING_OFF, AT, S);
    }
    if (PH & 64) {
        PHASE_IDS(); unsigned char* ws = ARG_WS;
        const float lam = ((const float*)(ws + WS_SCAL))[0];
        const float* ck = ARG_IN(2); const float* cv = ARG_IN(3); const int* pt = (const int*)ARG_IN(5); const float* subw = ARG_IN(13);
        for (int it = vcu; it < 512; it += G)
            dec::decode_attn_item(it, (const bf16*)(ws + WS_Q), (const bf16*)(ws + WS_K), (const bf16*)(ws + WS_V), ck, cv, pt, lam, subw, (bf16*)(ws + WS_MIX), (LAS float*)lds, tid, lane, wave);
    }
    xcd_barrier(bar);

    if (PH & 128) { PHASE_IDS(); unsigned char* ws = ARG_WS; const float* hn = ARG_IN(15);
        for (int it = vcu; it < 256; it += G) hgrn_c_item(it, (const float*)(ws + WS_LF), (const bf16*)(ws + WS_QH), (const bf16*)(ws + WS_KH), (const bf16*)(ws + WS_VH), (const bf16*)(ws + WS_GH),
                                                          (const bf16*)(ws + WS_HS), hn, (bf16*)(ws + WS_MIX), lds, tid, lane, wave); }
    if (PH & 256) {
        PHASE_IDS(); unsigned char* ws = ARG_WS; const float* subw = ARG_IN(13); const float* hn = ARG_IN(15);
        const float lam = ((const float*)(ws + WS_SCAL))[0];
        for (int m = gw; m < MP; m += NGW) mix_attn_row((const bf16*)(ws + WS_O16), lam, subw, (bf16*)(ws + WS_MIX), (size_t)m, lane);
        for (int m = gw; m < MS; m += NGW) mix_hgrn_row((const float*)(ws + WS_OHS), (const bf16*)(ws + WS_GH), hn, (bf16*)(ws + WS_MIX), m, lane);
    }
    xcd_barrier(bar);

    if (PH & 512) {
        unsigned char* ws = ARG_WS;
        pg8::Gemm g{(bf16*)(ws + WS_MIX), (bf16*)(ws + WS_WOUT), MT, DM, DM}; pg8::StaticOrder S; S.init(MT, DM, G, bx);
        EpiResF32 E{ARG_IN(0), ARG_IN(1), (float*)(ws + WS_X1)};
        pg8::gemm_phase<EpiResF32, pg8::StaticOrder, PG8_ALIGN, PG8_SP2>(lds + RING_OFF, g, S, E);
    }
    xcd_barrier(bar);

    if (PH & 1024) { PHASE_IDS(); unsigned char* ws = ARG_WS; const float* gn = ARG_IN(16);
        for (int m = gw; m < MT; m += NGW) rms_row_to_bf16((const float*)(ws + WS_X1) + (size_t)m * DM, gn, (bf16*)(ws + WS_XN) + (size_t)m * DM, lane); }
    xcd_barrier(bar);

    if (PH & 2048) {
        unsigned char* ws = ARG_WS;
        pg8::Gemm g{(bf16*)(ws + WS_XN), (bf16*)(ws + WS_WGU), MT, NGU, DM}; pg8::StaticOrder S; S.init(MT, NGU, G, bx);
        EpiSwiGLU E{(bf16*)(ws + WS_ACT)};
        pg8::gemm_phase<EpiSwiGLU, pg8::StaticOrder, PG8_ALIGN, PG8_SP2>(lds + RING_OFF, g, S, E);
    }
    xcd_barrier(bar);

    if (PH & 4096) {
        unsigned char* ws = ARG_WS;
        pg8::Gemm g{(bf16*)(ws + WS_ACT), (bf16*)(ws + WS_WDN), MT, DM, DFF}; pg8::StaticOrder S; S.init(MT, DM, G, bx);
        EpiResF32 E{(const float*)(ws + WS_X1), (const float*)(ws + WS_X1) + (size_t)MP * DM, ARG_OUT + OY};
        pg8::gemm_phase<EpiResF32, pg8::StaticOrder, PG8_ALIGN, PG8_SP2>(lds + RING_OFF, g, S, E);
    }
    xcd_barrier(bar);

    if (PH & 8192) { PHASE_IDS(); float* out = ARG_OUT; const float* gn = ARG_IN(20);
        for (int m = gw; m < MT; m += NGW) rms_row_inplace(out + OY + (size_t)m * DM, gn, lane); }
}

extern "C" void kernel_launch(void* const* d_in, const int* in_sizes, int n_in, void* d_out, int out_size, void* d_ws, size_t ws_size, hipStream_t stream) {
    static int grid = 0;
    if (grid == 0) {
        if (n_in != 21 || ws_size < WS_END) { fprintf(stderr, "kernel_launch: unexpected problem (n_in %d, ws %zu)\n", n_in, ws_size); grid = -1; return; }
        int dev = 0, cus = 0, per_cu = 0;
        if (hipGetDevice(&dev) != hipSuccess || hipDeviceGetAttribute(&cus, hipDeviceAttributeMultiprocessorCount, dev) != hipSuccess) { grid = -1; return; }
        if (hipFuncSetAttribute((const void*)hybrid_fwd, hipFuncAttributeMaxDynamicSharedMemorySize, LDS_BYTES) != hipSuccess) { fprintf(stderr, "kernel_launch: hipFuncSetAttribute failed\n"); grid = -1; return; }
        if (hipOccupancyMaxActiveBlocksPerMultiprocessor(&per_cu, (const void*)hybrid_fwd, NTHR, LDS_BYTES) != hipSuccess || per_cu < 1)
            fprintf(stderr, "kernel_launch: note: occupancy query reports %d workgroups per CU\n", per_cu);
        (void)hipGetLastError();
        grid = cus > 256 ? 256 : cus;
    }
    if (grid < 0) return;
    if (hipMemsetAsync((char*)d_ws + WS_CTL, 0, CTL_ZERO_BYTES, stream) != hipSuccess) { fprintf(stderr, "kernel_launch: memset failed\n"); return; }
    Args a{};
    for (int i = 0; i < 21; ++i) a.in[i] = (const float*)d_in[i];
    a.out = (float*)d_out; a.ws = (unsigned char*)d_ws;
    hipLaunchKernelGGL(hybrid_fwd, dim3(grid), dim3(NTHR), LDS_BYTES, stream, a);
    const hipError_t le = hipPeekAtLastError();
    if (le != hipSuccess) fprintf(stderr, "kernel_launch: launch failed: %s\n", hipGetErrorName(le));
}
```

```cpp
#include <hip/hip_runtime.h>
#include <cstdio>
#include <cstdint>
__device__ __forceinline__ int opaque_tid() { int t = threadIdx.x; asm volatile("" : "+v"(t)); return t; }
namespace pg8 {
#define PG8_LAS __attribute__((address_space(3)))
typedef unsigned short bf16_t;
typedef short bf16x8 __attribute__((ext_vector_type(8)));
typedef float f32x4 __attribute__((ext_vector_type(4)));
typedef unsigned u32x4 __attribute__((ext_vector_type(4)));
constexpr int BM = 256, BK = 64, HALF = 128, HTB = HALF * BK * 2  , STAGE_BYTES = 8 * HTB, NXCD = 8, WGM = 8;

__host__ __device__ __forceinline__ int lds_byte(int r, int c) { const int st = (r >> 4) * 2 + (c >> 5), rr = r & 15, cc = c & 31, ob = rr * 64 + cc * 2; return st * 1024 + (ob ^ (((ob >> 9) & 1) << 5)); }
__host__ __device__ __forceinline__ void stage_rc(int b, int& R, int& C) { const int st = b / 1024, sb = b % 1024, swz = sb ^ (((sb >> 9) & 1) << 5); R = (st >> 1) * 16 + swz / 64; C = (st & 1) * 32 + (swz % 64) / 2; }
__host__ __device__ __forceinline__ int perm32(int rho) { const int n = rho >> 4, i = rho & 15; return 8 * (i >> 2) + 4 * n + (i & 3); }

struct Unit { int pm, pn; };
struct Gemm { const bf16_t* A; const bf16_t* Bt; int M, N, K; };

struct StaticOrder {
    int nM, nN, nwg, G, c;
    __host__ __device__ void init(int M, int N, int G_, int c_) { nM = M / BM; nN = N / BM; nwg = nM * nN; G = G_; c = c_; }
    __host__ __device__ bool next(int i, Unit& u) const {
        const long L = (long)i * G + c; if (L >= nwg) return false;
        int wgid = (int)L; { const int q = nwg / NXCD, r = nwg % NXCD, xcd = wgid % NXCD, off = wgid / NXCD; wgid = (xcd < r ? xcd * (q + 1) : r * (q + 1) + (xcd - r) * q) + off; }
        const int nig = WGM * nN, gid = wgid / nig, fm = gid * WGM, gsz = (nM - fm) < WGM ? (nM - fm) : WGM;
        u.pm = fm + ((wgid % nig) % gsz); u.pn = (wgid % nig) / gsz; return true;
    }
    __device__ __forceinline__ void a_ready(const Unit&) const {}
    __device__ __forceinline__ void done(const Unit&) const {}
};

__device__ __forceinline__ unsigned cvt_pk_bf16(float lo, float hi) { unsigned r; asm volatile("v_cvt_pk_bf16_f32 %0, %1, %2" : "=v"(r) : "v"(lo), "v"(hi)); return r; }
typedef float f32x2 __attribute__((ext_vector_type(2)));
__device__ __forceinline__ f32x2 gelu_pk(f32x2 v) {
    const f32x2 av = __builtin_elementwise_abs(v), d = av * 0.2316418882f + 1.0f;
    f32x2 t; t.x = __builtin_amdgcn_rcpf(d.x); t.y = __builtin_amdgcn_rcpf(d.y);
    f32x2 q = t * 0.5307027145f + (-0.7265760135f); q = q * t + 0.7107068705f; q = q * t + (-0.142248368f); q = q * t + 0.127414796f; q = q * t;
    const f32x2 s = (v * v) * (-0.72134752044f);
    f32x2 e; e.x = __builtin_amdgcn_exp2f(s.x); e.y = __builtin_amdgcn_exp2f(s.y);
    const f32x2 m = v * (q * e), r = v - m;
    f32x2 o; o.x = v.x < 0.f ? m.x : r.x; o.y = v.y < 0.f ? m.y : r.y; return o;
}

template <int ACT  > struct EpiBf16 {
    static constexpr bool PERM = true, AFTER_DRAIN = false; static_assert(ACT == 0 || ACT == 1, "EpiBf16: ACT is 0 (none) or 1 (gelu_pk)");
    bf16_t* O; int ldc; const float* bias; int split_cols; size_t split_stride; float scale0;
    __device__ __forceinline__ void operator()(const f32x4 (&acc)[2][2][4][2], const Unit& u, int wr, int wc, int fr, int fq) const {
        const int row0 = u.pm * BM + wr * 64 + fr; int colt = u.pn * BM; bf16_t* base = O;
        float sc = 1.f; if (split_cols) { const int t = colt / split_cols; base += (size_t)t * split_stride; colt -= t * split_cols; if (t == 0) sc = scale0; }
        const int col0 = colt + wc * 32 + 8 * fq, bcol0 = u.pn * BM + wc * 32 + 8 * fq;
        f32x4 bv[2][2];
#pragma unroll
        for (int bj = 0; bj < 2; ++bj)
#pragma unroll
            for (int n = 0; n < 2; ++n) bv[bj][n] = bias ? *(const f32x4*)(bias + bcol0 + bj * HALF + 4 * n) : (f32x4){0.f, 0.f, 0.f, 0.f};
#pragma unroll
        for (int ai = 0; ai < 2; ++ai)
#pragma unroll
            for (int m = 0; m < 4; ++m) { bf16_t* rowp = base + (size_t)(row0 + ai * HALF + m * 16) * ldc + col0;
#pragma unroll
                for (int bj = 0; bj < 2; ++bj) { f32x4 v0 = acc[ai][bj][m][0] + bv[bj][0], v1 = acc[ai][bj][m][1] + bv[bj][1];
                    if (ACT == 1) { f32x2 a = gelu_pk((f32x2){v0[0], v0[1]}), b = gelu_pk((f32x2){v0[2], v0[3]}), c = gelu_pk((f32x2){v1[0], v1[1]}), d = gelu_pk((f32x2){v1[2], v1[3]});
                        v0 = (f32x4){a.x, a.y, b.x, b.y}; v1 = (f32x4){c.x, c.y, d.x, d.y}; }
                    v0 = v0 * sc; v1 = v1 * sc; u32x4 w; w.x = cvt_pk_bf16(v0[0], v0[1]); w.y = cvt_pk_bf16(v0[2], v0[3]); w.z = cvt_pk_bf16(v1[0], v1[1]); w.w = cvt_pk_bf16(v1[2], v1[3]);
                    *(u32x4*)(rowp + bj * HALF) = w; } }
    }
};
template <class Epi, class Sched, bool ALIGN_EPI = false, bool SP2 = false>
__device__ __forceinline__ void gemm_phase(PG8_LAS unsigned char* lds, const Gemm g, const Sched& S, const Epi& E) {
    const int tid = opaque_tid(), wid = __builtin_amdgcn_readfirstlane(tid >> 6), lane = tid & 63, wr = wid >> 2, wc = wid & 3, fr = lane & 15, fq = lane >> 4;
    const int K = g.K, nt = K / BK;
    unsigned voffA[2], voffB[2];
#pragma unroll
    for (int i = 0; i < 2; ++i) { int R, C; stage_rc(tid * 16 + i * 8192, R, C); const int Rb = Epi::PERM ? ((R & ~31) + perm32(R & 31)) : R;
        voffA[i] = (unsigned)(R * K + C) * 2u; voffB[i] = (unsigned)(Rb * K + C) * 2u; }
    const size_t kstep = (size_t)(BK * 2);
    const size_t hstep = (size_t)HALF * K * 2;
    const size_t tstep = 2 * hstep;
    const unsigned ldsw = (unsigned)wid * 1024u;
    const int aoff = lds_byte(wr * 64 + fr, fq * 8), boff = lds_byte(wc * 32 + fr, fq * 8);
#define PG8_SA(b, h) (((b) * 2 + (h)) * HTB)
#define PG8_SB(b, h) ((4 + (b) * 2 + (h)) * HTB)
#define PG8_STAGE(bufoff, gbase, voff) do { _Pragma("unroll") for (int _i = 0; _i < 2; ++_i) \
        __builtin_amdgcn_global_load_lds((const unsigned*)((const char*)(gbase) + (voff)[_i]), (PG8_LAS unsigned*)(lds + (bufoff) + ldsw + _i * 8192), 16, 0, 0); } while (0)
#define PG8_LDA(dst, b, h) do { _Pragma("unroll") for (int m = 0; m < 4; ++m) _Pragma("unroll") for (int k = 0; k < 2; ++k) dst[m][k] = *(const PG8_LAS bf16x8*)(lds + PG8_SA(b, h) + aoff + m * 2048 + k * 1024); } while (0)
#define PG8_LDB(dst, b, h) do { _Pragma("unroll") for (int n = 0; n < 2; ++n) _Pragma("unroll") for (int k = 0; k < 2; ++k) dst[n][k] = *(const PG8_LAS bf16x8*)(lds + PG8_SB(b, h) + boff + n * 2048 + k * 1024); } while (0)
#define PG8_MMA(ai, bj, At, Bt) do { __builtin_amdgcn_s_setprio(1); _Pragma("unroll") for (int m = 0; m < 4; ++m) _Pragma("unroll") for (int n = 0; n < 2; ++n) _Pragma("unroll") for (int k = 0; k < 2; ++k) \
        acc[ai][bj][m][n] = __builtin_amdgcn_mfma_f32_16x16x32_bf16(Bt[n][k], At[m][k], acc[ai][bj][m][n], 0, 0, 0); __builtin_amdgcn_s_setprio(0); } while (0)
#define PG8_WAIT_V(n) asm volatile("s_waitcnt vmcnt(" #n ")" ::: "memory")
#define PG8_WAIT_L(n) asm volatile("s_waitcnt lgkmcnt(" #n ")" ::: "memory")
#define PG8_BAR __builtin_amdgcn_s_barrier()
#define PG8_SCHED __builtin_amdgcn_sched_barrier(0)
    Unit cur, nxt; int ui = 0;
    if (!S.next(0, cur)) return;
    f32x4 acc[2][2][4][2];
#pragma unroll
    for (int a = 0; a < 2; ++a)
#pragma unroll
        for (int b = 0; b < 2; ++b)
#pragma unroll
            for (int m = 0; m < 4; ++m)
#pragma unroll
                for (int n = 0; n < 2; ++n) acc[a][b][m][n] = (f32x4){0.f, 0.f, 0.f, 0.f};
    bf16x8 At[4][2], B0[2][2], B1[2][2];
    const char* cA = (const char*)g.A + (size_t)cur.pm * tstep; const char* cB = (const char*)g.Bt + (size_t)cur.pn * tstep;
    S.a_ready(cur);
    if constexpr (SP2) {
        PG8_STAGE(PG8_SB(0, 0), cB, voffB); PG8_STAGE(PG8_SB(0, 1), cB + hstep, voffB); PG8_STAGE(PG8_SA(0, 0), cA, voffA); PG8_STAGE(PG8_SA(0, 1), cA + hstep, voffA);
        if (wr == 1) PG8_BAR;
        PG8_WAIT_V(2); PG8_BAR;
        PG8_STAGE(PG8_SB(1, 0), cB + kstep, voffB); PG8_STAGE(PG8_SA(1, 0), cA + kstep, voffA); PG8_STAGE(PG8_SB(1, 1), cB + hstep + kstep, voffB);
        PG8_WAIT_V(6); PG8_BAR;
    } else {
        PG8_STAGE(PG8_SB(0, 0), cB, voffB); PG8_STAGE(PG8_SA(0, 0), cA, voffA); PG8_STAGE(PG8_SB(0, 1), cB + hstep, voffB); PG8_STAGE(PG8_SA(0, 1), cA + hstep, voffA);
        if (wr == 1) PG8_BAR;
        PG8_WAIT_V(4); PG8_BAR;
        PG8_STAGE(PG8_SB(1, 0), cB + kstep, voffB); PG8_STAGE(PG8_SA(1, 0), cA + kstep, voffA); PG8_STAGE(PG8_SB(1, 1), cB + hstep + kstep, voffB);
        PG8_WAIT_V(6); PG8_BAR;
    }
    for (;;) {
        const bool has_next = S.next(ui + 1, nxt);
        const char* nA = has_next ? (const char*)g.A + (size_t)nxt.pm * tstep : cA; const char* nB = has_next ? (const char*)g.Bt + (size_t)nxt.pn * tstep : cB;
        for (int t = 0; t < nt; t += 2) {
            const bool last = (t == nt - 2);
            const char* a1 = cA + (size_t)(t + 1) * kstep;
            const char* a2 = last ? nA : cA + (size_t)(t + 2) * kstep; const char* b2 = last ? nB : cB + (size_t)(t + 2) * kstep;
            const char* a3 = a2 + kstep; const char* b3 = b2 + kstep;
            if (last && has_next) S.a_ready(nxt);
            if constexpr (SP2) {
            PG8_LDB(B0, 0, 0); PG8_LDB(B1, 0, 1); PG8_SCHED; PG8_LDA(At, 0, 0); PG8_STAGE(PG8_SA(1, 1), a1 + hstep, voffA);
            PG8_WAIT_V(8); PG8_WAIT_L(0); PG8_BAR; PG8_MMA(0, 0, At, B0); PG8_MMA(0, 1, At, B1); PG8_BAR; PG8_SCHED;
            PG8_LDA(At, 0, 1); PG8_STAGE(PG8_SB(0, 0), b2, voffB); PG8_STAGE(PG8_SB(0, 1), b2 + hstep, voffB); PG8_STAGE(PG8_SA(0, 0), a2, voffA);
            PG8_WAIT_V(8); PG8_WAIT_L(0); PG8_BAR; PG8_MMA(1, 0, At, B0); PG8_MMA(1, 1, At, B1); PG8_BAR; PG8_SCHED;
            PG8_LDB(B0, 1, 0); PG8_LDB(B1, 1, 1); PG8_SCHED; PG8_LDA(At, 1, 0); PG8_STAGE(PG8_SA(0, 1), a2 + hstep, voffA);
            PG8_WAIT_V(8); PG8_WAIT_L(0); PG8_BAR; PG8_MMA(0, 0, At, B0); PG8_MMA(0, 1, At, B1); PG8_BAR; PG8_SCHED;
            PG8_LDA(At, 1, 1); PG8_STAGE(PG8_SB(1, 0), b3, voffB); PG8_STAGE(PG8_SB(1, 1), b3 + hstep, voffB); PG8_STAGE(PG8_SA(1, 0), a3, voffA);
            PG8_WAIT_V(8); PG8_WAIT_L(0); PG8_BAR; PG8_MMA(1, 0, At, B0); PG8_MMA(1, 1, At, B1); PG8_BAR; PG8_SCHED;
            } else {
            PG8_LDB(B0, 0, 0); PG8_SCHED; PG8_LDA(At, 0, 0); PG8_STAGE(PG8_SA(1, 1), a1 + hstep, voffA);
            PG8_WAIT_L(8); PG8_BAR; PG8_WAIT_L(0); PG8_MMA(0, 0, At, B0); PG8_BAR; PG8_SCHED;
            PG8_LDB(B1, 0, 1); PG8_STAGE(PG8_SB(0, 0), b2, voffB);
            PG8_BAR; PG8_WAIT_L(0); PG8_MMA(0, 1, At, B1); PG8_BAR;
            PG8_LDA(At, 0, 1); PG8_STAGE(PG8_SA(0, 0), a2, voffA);
            PG8_BAR; PG8_WAIT_L(0); PG8_MMA(1, 0, At, B0); PG8_BAR; PG8_SCHED;
            PG8_STAGE(PG8_SB(0, 1), b2 + hstep, voffB);
            PG8_WAIT_V(6); PG8_BAR; PG8_MMA(1, 1, At, B1); PG8_BAR;
            PG8_LDB(B0, 1, 0); PG8_SCHED; PG8_LDA(At, 1, 0); PG8_STAGE(PG8_SA(0, 1), a2 + hstep, voffA);
            PG8_WAIT_L(8); PG8_BAR; PG8_WAIT_L(0); PG8_MMA(0, 0, At, B0); PG8_BAR; PG8_SCHED;
            PG8_LDB(B1, 1, 1); PG8_STAGE(PG8_SB(1, 0), b3, voffB);
            PG8_BAR; PG8_WAIT_L(0); PG8_MMA(0, 1, At, B1); PG8_BAR;
            PG8_LDA(At, 1, 1); PG8_STAGE(PG8_SA(1, 0), a3, voffA);
            PG8_BAR; PG8_WAIT_L(0); PG8_MMA(1, 0, At, B0); PG8_BAR; PG8_SCHED;
            PG8_STAGE(PG8_SB(1, 1), b3 + hstep, voffB);
            PG8_WAIT_V(6); PG8_BAR; PG8_MMA(1, 1, At, B1); PG8_BAR;
            }
        }
        if constexpr (ALIGN_EPI) { if (wr == 0) PG8_BAR; }
        if constexpr (!Epi::AFTER_DRAIN) { E(acc, cur, wr, wc, fr, fq); S.done(cur); }
        if (!has_next) break;
#pragma unroll
        for (int a = 0; a < 2; ++a)
#pragma unroll
            for (int b = 0; b < 2; ++b)
#pragma unroll
                for (int m = 0; m < 4; ++m)
#pragma unroll
                    for (int n = 0; n < 2; ++n) acc[a][b][m][n] = (f32x4){0.f, 0.f, 0.f, 0.f};
        cur = nxt; cA = nA; cB = nB; ++ui;
        if constexpr (ALIGN_EPI) { if (wr == 1) PG8_BAR; }
    }
    PG8_WAIT_V(0);
    if constexpr (!ALIGN_EPI) { if (wr == 0) PG8_BAR; }
    PG8_BAR;
    if constexpr (Epi::AFTER_DRAIN) { E.fused(acc, cur, wr, wc, fr, fq, lds, wid, lane); S.done(cur); }
#undef PG8_SA
#undef PG8_SB
#undef PG8_STAGE
#undef PG8_LDA
#undef PG8_LDB
#undef PG8_MMA
#undef PG8_WAIT_V
#undef PG8_WAIT_L
#undef PG8_BAR
#undef PG8_SCHED
}
}

#ifndef PG8_SP2
#define PG8_SP2 true
#endif
#ifndef PG8_ALIGN
#define PG8_ALIGN true
#endif
#include <hip/hip_bf16.h>
#include <cmath>
namespace attn_body {
using bf16=__hip_bfloat16;
using bf16x8=__attribute__((ext_vector_type(8)))short;
using s16x4=__attribute__((ext_vector_type(4)))short;
using f32x16=__attribute__((ext_vector_type(16)))float;
using u32x4=__attribute__((ext_vector_type(4)))unsigned;
constexpr int BATCH=2,NHEAD=16,SEQ=8192,D=64,DM=NHEAD*D;
constexpr int PQK=512, PO=1024;
constexpr int NW=8,QBLK=32,QB=QBLK*NW,KVBLK=64,NQB=SEQ/QB;
constexpr int ATTN_PITCH=DM, ATTN_UNIT_ROWS=QB;
__device__ __forceinline__ int crow(int r,int hi){return (r&3)+8*(r>>2)+4*hi;}
#define SBAR() __builtin_amdgcn_sched_barrier(0)
__device__ __forceinline__ void cmask(f32x16&p0,f32x16&p1,int jb,int qrel,int hi){
  const float NEG=-INFINITY; int kb=64*jb+4*hi;
  #pragma unroll
  for(int r=0;r<16;++r){int kv=kb+(r&3)+8*(r>>2); if(kv>qrel)p0[r]=NEG; if(kv+32>qrel)p1[r]=NEG;}
}

constexpr int NSLOT=3, SLOTB=8192;
constexpr int LDS_K=0, LDS_V=NSLOT*SLOTB, LDS_WS=2*NSLOT*SLOTB, LDS_OST=LDS_WS+NW*64*4, LDS_BYTES=LDS_OST+NW*4096;
constexpr float C2=0.125f*1.4426950408889634f;
__device__ __forceinline__ void glds16(const void*gsrc,unsigned lds_dst){unsigned keep;
  asm volatile("s_mov_b32 %0, m0\n\ts_mov_b32 m0, %2\n\ts_nop 0\n\tglobal_load_lds_dwordx4 %1, off\n\ts_mov_b32 m0, %0":"=&s"(keep):"v"(gsrc),"s"(lds_dst):"memory");}
__device__ __forceinline__ float max3f(float a,float b,float c){float r;asm("v_max3_f32 %0, %1, %2, %3":"=v"(r):"v"(a),"v"(b),"v"(c));return r;}
__device__ __forceinline__ float max2f(float a,float b){float r;asm("v_max_f32_e32 %0, %1, %2":"=v"(r):"v"(a),"v"(b));return r;}
__device__ __forceinline__ float fadd_s(float a,float b){float r;asm("v_add_f32_e32 %0, %1, %2":"=v"(r):"v"(a),"v"(b));return r;}
__device__ __forceinline__ float fsub_s(float a,float b){float r;asm("v_sub_f32_e32 %0, %1, %2":"=v"(r):"v"(a),"v"(b));return r;}
typedef float f32x2_t __attribute__((ext_vector_type(2))); typedef __bf16 bf16x2_t __attribute__((ext_vector_type(2)));
__device__ __forceinline__ unsigned cvtpk_s(float lo,float hi){f32x2_t v={lo,hi};bf16x2_t b=__builtin_convertvector(v,bf16x2_t);return __builtin_bit_cast(unsigned,b);}
#define WAIT_BAR(N) asm volatile("s_waitcnt vmcnt(" #N ") lgkmcnt(0)\n\ts_barrier":::"memory")

__device__ __forceinline__ void qkt(f32x16&p0,f32x16&p1,const char*Kslot,const bf16x8*qr,const f32x16&negm,int r32,int hi){
  const char*kb=Kslot+hi*1024+r32*16;
  #pragma unroll
  for(int d0=0;d0<4;++d0){
    const bf16x8 b0=*reinterpret_cast<const bf16x8*>(kb+d0*2048);
    const bf16x8 b1=*reinterpret_cast<const bf16x8*>(kb+d0*2048+512);
    if(d0==0){p0=__builtin_amdgcn_mfma_f32_32x32x16_bf16(b0,qr[0],negm,0,0,0);p1=__builtin_amdgcn_mfma_f32_32x32x16_bf16(b1,qr[0],negm,0,0,0);}
    else{p0=__builtin_amdgcn_mfma_f32_32x32x16_bf16(b0,qr[d0],p0,0,0,0);p1=__builtin_amdgcn_mfma_f32_32x32x16_bf16(b1,qr[d0],p1,0,0,0);}}
}
typedef __attribute__((address_space(3))) const char* lds_cptr;
typedef short v4i16_t __attribute__((ext_vector_type(4)));
__device__ __forceinline__ void kload8(bf16x8*kf,lds_cptr kp){
  kf[0]=*(const __attribute__((address_space(3))) bf16x8*)(kp);      kf[1]=*(const __attribute__((address_space(3))) bf16x8*)(kp+512);
  kf[2]=*(const __attribute__((address_space(3))) bf16x8*)(kp+2048); kf[3]=*(const __attribute__((address_space(3))) bf16x8*)(kp+2560);
  kf[4]=*(const __attribute__((address_space(3))) bf16x8*)(kp+4096); kf[5]=*(const __attribute__((address_space(3))) bf16x8*)(kp+4608);
  kf[6]=*(const __attribute__((address_space(3))) bf16x8*)(kp+6144); kf[7]=*(const __attribute__((address_space(3))) bf16x8*)(kp+6656);
}
__device__ __forceinline__ void kload2(bf16x8*kf,lds_cptr kp,int j){ kf[2*j]=*(const __attribute__((address_space(3))) bf16x8*)(kp+j*2048); kf[2*j+1]=*(const __attribute__((address_space(3))) bf16x8*)(kp+j*2048+512); }
__device__ __forceinline__ s16x4 vtr(lds_cptr p){ return __builtin_bit_cast(s16x4,__builtin_amdgcn_ds_read_tr16_b64_v4i16((__attribute__((address_space(3))) v4i16_t*)p)); }
__device__ __forceinline__ float rowmax(const f32x16&p0,const f32x16&p1){
  float a=max3f(p0[0],p0[1],p1[0]),b=max3f(p0[2],p0[3],p1[1]);a=max3f(a,p1[2],p1[3]);
  #pragma unroll
  for(int r=4;r<16;r+=4){a=max3f(a,p0[r],p0[r+1]);b=max3f(b,p0[r+2],p0[r+3]);a=max3f(a,p1[r],p1[r+1]);b=max3f(b,p1[r+2],p1[r+3]);}
  const float m=max2f(a,b);
  auto rr=__builtin_amdgcn_permlane32_swap(__float_as_uint(m),__float_as_uint(m),false,false);
  return max2f(__uint_as_float(rr[0]),__uint_as_float(rr[1]));
}
__device__ __forceinline__ void pv(f32x16*o,int vb,bf16x8 pa0,bf16x8 pa1,bf16x8 pa2,bf16x8 pa3){
  #pragma unroll
  for(int d0=0;d0<2;++d0){s16x4 lo[4],hi[4];
    #pragma unroll
    for(int ks=0;ks<4;++ks){
      asm volatile("ds_read_b64_tr_b16 %0,%1 offset:%c2":"=&v"(lo[ks]):"v"(vb),"i"(d0*4096+ks*1024):"memory");
      asm volatile("ds_read_b64_tr_b16 %0,%1 offset:%c2":"=&v"(hi[ks]):"v"(vb),"i"(d0*4096+ks*1024+512):"memory");}
    asm volatile("s_waitcnt lgkmcnt(0)":::"memory");SBAR();
    #define PK(k) (bf16x8){lo[k][0],lo[k][1],lo[k][2],lo[k][3],hi[k][0],hi[k][1],hi[k][2],hi[k][3]}
    o[d0]=__builtin_amdgcn_mfma_f32_32x32x16_bf16(pa0,PK(0),o[d0],0,0,0);
    o[d0]=__builtin_amdgcn_mfma_f32_32x32x16_bf16(pa1,PK(1),o[d0],0,0,0);
    o[d0]=__builtin_amdgcn_mfma_f32_32x32x16_bf16(pa2,PK(2),o[d0],0,0,0);
    o[d0]=__builtin_amdgcn_mfma_f32_32x32x16_bf16(pa3,PK(3),o[d0],0,0,0);
    #undef PK
  }
}

#ifndef ATTN_STORE16
#define ATTN_STORE16(p,v) (*(u32x4*)(p)=(v))
#endif
template<int THRL> __device__ __forceinline__ void attn_unit(int b,int h,int qb,const bf16*Q,const bf16*__restrict__ K,const bf16*__restrict__ V,bf16*O,char*shm){
  const int tid=opaque_tid(),lane=tid&63,r32=lane&31,hi=lane>>5; const int wid=__builtin_amdgcn_readfirstlane(tid>>6);
  const long rowbase=(long)b*SEQ; const int q0=qb*QB;
  const int qkcol=(h>>2)*128+((h>>1)&1)*64, vcol=(h>>2)*128+(h&1)*64;
  const bf16*Qw=Q+(rowbase+q0+wid*QBLK)*PQK+qkcol;
  const bf16*Kh=K+rowbase*PQK+qkcol,*Vh=V+rowbase*PQK+vcol;
  const unsigned lds0=(unsigned)(uintptr_t)shm;
  float*wsf=(float*)(shm+LDS_WS)+wid*64;
  const bf16*ksrc=Kh+(long)lane*PQK+wid*8;
  const bf16*vsrc=Vh+(long)(16*(wid&3)+(lane>>2))*PQK+(wid>>2)*32+(lane&3)*8;
  const unsigned kdst=lds0+LDS_K+wid*1024, vdst=lds0+LDS_V+wid*1024;
  #define DMA_K(t,slot) glds16(ksrc+(long)(t)*KVBLK*PQK,(unsigned)__builtin_amdgcn_readfirstlane(kdst+(slot)))
  #define DMA_V(t,slot) glds16(vsrc+(long)(t)*KVBLK*PQK,(unsigned)__builtin_amdgcn_readfirstlane(vdst+(slot)))
  const int vb0=(int)(lds0+LDS_V)+((lane>>4)&1)*32+(lane&3)*8+(4*hi+((lane&15)>>2))*64;
  const char*Kbase=shm+LDS_K; bf16x8 kf[8];
  const lds_cptr shm3=(lds_cptr)shm; const lds_cptr kp0=shm3+LDS_K+hi*1024+r32*16; const lds_cptr vp0=shm3+LDS_V+((lane>>4)&1)*32+(lane&3)*8+(4*hi+((lane&15)>>2))*64;
  const int NT=(q0+QB)/KVBLK;
  DMA_K(0,0);DMA_V(0,0);DMA_K(1,SLOTB);
  bf16x8 qr[4];
  #pragma unroll
  for(int d0=0;d0<4;++d0)qr[d0]=*reinterpret_cast<const bf16x8*>(&Qw[(long)r32*PQK+d0*16+hi*8]);
  float mhat=0.f,l_reg=0.f;f32x16 o[2];o[0]=f32x16{};o[1]=f32x16{};f32x16 negm=f32x16{};asm volatile("":"+v"(negm));
  const int qrel=wid*QBLK+r32;
  #define CMASK(P0,P1,t) do{int jb_=(t)-(NT-4); if(jb_>=0)cmask(P0,P1,jb_,qrel,hi);}while(0)
  bool resc=false;
  #define START(P0,P1) do{ const float rm=rowmax(P0,P1); resc=false; \
    { const float dl=rm; mhat=fadd_s(mhat,dl); \
      _Pragma("unroll") for(int r=0;r<16;++r){P0[r]=fsub_s(P0[r],dl);P1[r]=fsub_s(P1[r],dl);} \
      _Pragma("unroll") for(int r=0;r<16;++r)negm[r]=-mhat; asm volatile("":"+v"(negm)); } \
    _Pragma("unroll") for(int r=0;r<16;++r)P0[r]=__builtin_amdgcn_exp2f(P0[r]); }while(0)
  #define RESC() do{ if(resc){ asm volatile("s_waitcnt lgkmcnt(0)":::"memory"); \
      _Pragma("unroll") for(int d_=0;d_<2;++d_) _Pragma("unroll") for(int r=0;r<16;++r)o[d_][r]*=wsf[crow(r,hi)]; } }while(0)
  f32x16 pA0,pA1,pB0,pB1;
  int sl_prev=0,sl_cur=0,sl_next=SLOTB;
  #define ROT() do{sl_prev=sl_cur;sl_cur=sl_next;sl_next=(sl_next==(NSLOT-1)*SLOTB)?0:sl_next+SLOTB;}while(0)
  DMA_K(2,2*SLOTB);
  WAIT_BAR(3);
  qkt(pA0,pA1,Kbase,qr,negm,r32,hi);asm volatile("s_nop 15\n\ts_nop 7":"+v"(pA0),"+v"(pA1));CMASK(pA0,pA1,0);
  START(pA0,pA1);
  _Pragma("unroll") for(int r=0;r<16;++r)pA1[r]=__builtin_amdgcn_exp2f(pA1[r]);
  WAIT_BAR(0);
  DMA_K(3,0);DMA_V(1,SLOTB);
  ROT();
  kload8(kf,kp0+sl_cur);
  WAIT_BAR(2);
  s16x4 vlo[8],vhi[8]; u32x4 pw0,pw1,pw2,pw3;
  #define PKW(P,B) cvtpk_s(P[B],P[B+1])
  #define PAF(k) __builtin_bit_cast(bf16x8,pw##k)
  #define VFR(i) (bf16x8){vlo[i][0],vlo[i][1],vlo[i][2],vlo[i][3],vhi[i][0],vhi[i][1],vhi[i][2],vhi[i][3]}
  #define PIN(x) asm volatile("":"+v"(x))
  #define MX3(a,b,c) __builtin_fmaxf(__builtin_fmaxf((a),(b)),(c))
  #define GAPA(MF,A0,A1,A2,A3,W0,W1,PW) do{ MF; sacc+=A0; sacc+=A1; sacc+=A2; sacc+=A3; PIN(sacc); W0; W1; PIN(PW); SBAR(); }while(0)
  #define EX(v) __builtin_amdgcn_exp2f(v)
  #define GAPB(MF,X,B) do{ MF; X[B]=EX(X[B]); X[B+1]=EX(X[B+1]); X[B+2]=EX(X[B+2]); X[B+3]=EX(X[B+3]); PIN(X); SBAR(); }while(0)
  #define VRD(i) do{ vlo[i]=vtr(vp_+(((i)>>2)*4096+((i)&3)*1024)); vhi[i]=vtr(vp_+(((i)>>2)*4096+((i)&3)*1024+512)); }while(0)
  #define KRD(G,j) do{ if(G){ kload2(kf,kp0+sl_next,j); SBAR(); } }while(0)
  #define STEP(C0,C1,P0,P1,t,GK,GV,GL) do{ SBAR(); \
    const lds_cptr vp_=vp0+sl_prev; \
    VRD(0); SBAR(); float sacc=(P0[0]+P0[1]); \
    GAPA(C0=__builtin_amdgcn_mfma_f32_32x32x16_bf16(kf[0],qr[0],negm,0,0,0), P0[2],P0[3],P0[4],P0[5],     pw0[0]=PKW(P0,0), pw0[1]=PKW(P0,2), pw0); \
    VRD(4); SBAR(); GAPA(C1=__builtin_amdgcn_mfma_f32_32x32x16_bf16(kf[1],qr[0],negm,0,0,0), P0[6],P0[7],P0[8],P0[9],     pw0[2]=PKW(P0,4), pw0[3]=PKW(P0,6), pw0); \
    VRD(1); SBAR(); GAPA(C0=__builtin_amdgcn_mfma_f32_32x32x16_bf16(kf[2],qr[1],C0,0,0,0),   P0[10],P0[11],P0[12],P0[13], pw1[0]=PKW(P0,8), pw1[1]=PKW(P0,10), pw1); \
    VRD(5); SBAR(); GAPA(C1=__builtin_amdgcn_mfma_f32_32x32x16_bf16(kf[3],qr[1],C1,0,0,0),   P0[14],P0[15],P1[0],P1[1],   pw1[2]=PKW(P0,12),pw1[3]=PKW(P0,14), pw1); \
    VRD(2); SBAR(); GAPA(C0=__builtin_amdgcn_mfma_f32_32x32x16_bf16(kf[4],qr[2],C0,0,0,0),   P1[2],P1[3],P1[4],P1[5],     pw2[0]=PKW(P1,0), pw2[1]=PKW(P1,2), pw2); \
    VRD(6); SBAR(); GAPA(C1=__builtin_amdgcn_mfma_f32_32x32x16_bf16(kf[5],qr[2],C1,0,0,0),   P1[6],P1[7],P1[8],P1[9],     pw2[2]=PKW(P1,4), pw2[3]=PKW(P1,6), pw2); \
    VRD(3); SBAR(); GAPA(C0=__builtin_amdgcn_mfma_f32_32x32x16_bf16(kf[6],qr[3],C0,0,0,0),   P1[10],P1[11],P1[12],P1[13], pw3[0]=PKW(P1,8), pw3[1]=PKW(P1,10), pw3); \
    VRD(7); SBAR(); GAPA(C1=__builtin_amdgcn_mfma_f32_32x32x16_bf16(kf[7],qr[3],C1,0,0,0),   P1[14],P1[15],0.f,0.f,       pw3[2]=PKW(P1,12),pw3[3]=PKW(P1,14), pw3); \
    l_reg+=sacc; \
    if(GK){DMA_K((t)+3,sl_cur);} if(GV){DMA_V((t)+1,sl_next);} \
    CMASK(C0,C1,t); \
    { float a=MX3(C0[0],C0[1],C1[0]),b=MX3(C0[2],C0[3],C1[1]); a=MX3(a,C1[2],C1[3]); \
      _Pragma("unroll") for(int r=4;r<16;r+=4){a=MX3(a,C0[r],C0[r+1]);b=MX3(b,C0[r+2],C0[r+3]);a=MX3(a,C1[r],C1[r+1]);b=MX3(b,C1[r+2],C1[r+3]);} \
      float rm=__builtin_fmaxf(a,b); { auto rr=__builtin_amdgcn_permlane32_swap(__float_as_uint(rm),__float_as_uint(rm),false,false); rm=__builtin_fmaxf(__uint_as_float(rr[0]),__uint_as_float(rr[1])); } \
      resc=false; \
      if(__builtin_expect(__any(rm>(float)THRL),0)){ const float dl=__builtin_fmaxf(rm,0.f); mhat+=dl; \
        _Pragma("unroll") for(int r=0;r<16;++r){C0[r]-=dl;C1[r]-=dl;} \
        _Pragma("unroll") for(int r=0;r<16;++r)negm[r]=-mhat; asm volatile("":"+v"(negm)); \
        const float f=__builtin_amdgcn_exp2f(-dl); l_reg*=f; if(hi==0)wsf[r32]=f; resc=true; } } \
    SBAR(); \
    GAPB(o[0]=__builtin_amdgcn_mfma_f32_32x32x16_bf16(PAF(0),VFR(0),o[0],0,0,0), C0,0); \
    GAPB(o[1]=__builtin_amdgcn_mfma_f32_32x32x16_bf16(PAF(0),VFR(4),o[1],0,0,0), C0,4); \
    KRD(GL,0); GAPB(o[0]=__builtin_amdgcn_mfma_f32_32x32x16_bf16(PAF(1),VFR(1),o[0],0,0,0), C0,8); \
    KRD(GL,1); GAPB(o[1]=__builtin_amdgcn_mfma_f32_32x32x16_bf16(PAF(1),VFR(5),o[1],0,0,0), C0,12); \
    KRD(GL,2); GAPB(o[0]=__builtin_amdgcn_mfma_f32_32x32x16_bf16(PAF(2),VFR(2),o[0],0,0,0), C1,0); \
    KRD(GL,3); GAPB(o[1]=__builtin_amdgcn_mfma_f32_32x32x16_bf16(PAF(2),VFR(6),o[1],0,0,0), C1,4); \
    GAPB(o[0]=__builtin_amdgcn_mfma_f32_32x32x16_bf16(PAF(3),VFR(3),o[0],0,0,0), C1,8); \
    GAPB(o[1]=__builtin_amdgcn_mfma_f32_32x32x16_bf16(PAF(3),VFR(7),o[1],0,0,0), C1,12); \
    }while(0)
  int t=1;
  #undef CMASK
  #define CMASK(P0,P1,t) do{}while(0)
  for(;t+5<NT;t+=2){
    STEP(pB0,pB1,pA0,pA1,t,true,true,true);     WAIT_BAR(2); RESC(); ROT();
    STEP(pA0,pA1,pB0,pB1,t+1,true,true,true);   WAIT_BAR(2); RESC(); ROT();
  }
  #undef CMASK
  #define CMASK(P0,P1,t) do{int jb_=(t)-(NT-4); if(jb_>=0)cmask(P0,P1,jb_,qrel,hi);}while(0)
  #define ENDW(tt) do{ if((tt)+3<NT){WAIT_BAR(2);} else if((tt)+2<NT){WAIT_BAR(1);} else {WAIT_BAR(0);} }while(0)
  for(;t+1<NT;t+=2){
    STEP(pB0,pB1,pA0,pA1,t,(t+3<NT),(t+1<NT),(t+1<NT));       ENDW(t);   RESC(); ROT();
    STEP(pA0,pA1,pB0,pB1,t+1,(t+4<NT),(t+2<NT),(t+2<NT));     ENDW(t+1); RESC(); ROT();
  }
  STEP(pB0,pB1,pA0,pA1,NT-1,false,false,false); RESC();
  { float sacc=pB0[0]+pB0[1]; _Pragma("unroll") for(int r=2;r<16;++r)sacc+=pB0[r]; _Pragma("unroll") for(int r=0;r<16;++r)sacc+=pB1[r]; l_reg+=sacc;
    pw0=(u32x4){PKW(pB0,0),PKW(pB0,2),PKW(pB0,4),PKW(pB0,6)};pw1=(u32x4){PKW(pB0,8),PKW(pB0,10),PKW(pB0,12),PKW(pB0,14)};pw2=(u32x4){PKW(pB1,0),PKW(pB1,2),PKW(pB1,4),PKW(pB1,6)};pw3=(u32x4){PKW(pB1,8),PKW(pB1,10),PKW(pB1,12),PKW(pB1,14)};
    SBAR(); pv(o,vb0+sl_cur,PAF(0),PAF(1),PAF(2),PAF(3)); }
  #undef PKW
  #undef PAF
  #undef VFR
  #undef PIN
  #undef MX3
  #undef GAPA
  #undef GAPB
  #undef EX
  #undef VRD
  #undef KRD
  #undef STEP
  #undef ENDW
  {auto rr=__builtin_amdgcn_permlane32_swap(__float_as_uint(l_reg),__float_as_uint(l_reg),false,false);l_reg=__uint_as_float(rr[0])+__uint_as_float(rr[1]);}
  if(hi==0)wsf[32+r32]=l_reg;asm volatile("s_waitcnt lgkmcnt(0)":::"memory");
  float rli[16];
  #pragma unroll
  for(int r=0;r<16;++r)rli[r]=__builtin_amdgcn_rcpf(wsf[32+crow(r,hi)]);
  bf16*Ow=O+(rowbase+q0+wid*QBLK)*PO+h*D;
  { bf16*stg=(bf16*)(shm+LDS_OST)+wid*2048;
    #pragma unroll
    for(int r=0;r<16;++r){const int orow=crow(r,hi);
      #pragma unroll
      for(int d0=0;d0<2;++d0)stg[orow*64+d0*32+r32]=__float2bfloat16(o[d0][r]*rli[r]);}
    asm volatile("s_waitcnt lgkmcnt(0)":::"memory");
    #pragma unroll
    for(int i=0;i<4;++i){const int row=i*8+(lane>>3),ch=lane&7; const u32x4 v=*(const u32x4*)(stg+row*64+ch*8); ATTN_STORE16(Ow+(long)row*PO+ch*8,v);} }
  asm volatile("s_waitcnt lgkmcnt(0)\n\ts_barrier":::"memory");
  #undef DMA_K
  #undef DMA_V
  #undef CMASK
  #undef START
  #undef RESC
  #undef ROT
}
constexpr int ATTN_LDS_BYTES=LDS_BYTES;
struct AttnTensors { const bf16* Q; const bf16* K; const bf16* V; bf16* O; };
struct AttnUnit { int bh; int qb; };
struct StaticOrder {
  int vcu;
  __device__ __forceinline__ explicit StaticOrder(int grid,int block):vcu((block%8)*(grid/8)+block/8){}
  __device__ __forceinline__ bool next(int i,AttnUnit&u)const{ if(i>=4)return false; const int s=vcu&7; u.bh=vcu>>3; u.qb=(i==0)?s:(i==1)?15-s:(i==2)?16+s:31-s; return true; }
  __device__ __forceinline__ void a_ready(const AttnUnit&)const{}
  __device__ __forceinline__ void done(const AttnUnit&)const{}
};
template<class Sched,int THRL=8> __device__ __forceinline__ void attn_phase(char*lds,const AttnTensors&T,const Sched&S){
  AttnUnit u;
  for(int i=0;S.next(i,u);++i){ S.a_ready(u); attn_unit<THRL>(u.bh/NHEAD,u.bh%NHEAD,u.qb,T.Q,T.K,T.V,T.O,lds); S.done(u); }
}
#undef SBAR
#undef WAIT_BAR
}
#define GAS __attribute__((address_space(1)))
#define LAS __attribute__((address_space(3)))
typedef unsigned short bf16;
typedef unsigned v4u __attribute__((ext_vector_type(4)));
typedef float f32x4 __attribute__((ext_vector_type(4)));
typedef short bf16x8 __attribute__((ext_vector_type(8)));
typedef GAS unsigned gu32;
typedef GAS unsigned long long gu64;
#define RLX_AGENT __ATOMIC_RELAXED, __HIP_MEMORY_SCOPE_AGENT
#define LDS_WAIT() asm volatile("s_waitcnt lgkmcnt(0)" ::: "memory")
#define VM_WAIT() asm volatile("s_waitcnt vmcnt(0)" ::: "memory")
__device__ __forceinline__ unsigned long long rt() { return __builtin_amdgcn_s_memrealtime(); }
__device__ __forceinline__ unsigned f2bf(float f) { unsigned u = __builtin_bit_cast(unsigned, f); return (u + 0x7fffu + ((u >> 16) & 1u)) >> 16; }
__device__ __forceinline__ unsigned pk2(float lo, float hi) { return f2bf(lo) | (f2bf(hi) << 16); }

#define XB_TMO      128
#define XB_XCNT(j)  (256  + 64 * (j))
#define XB_XSUB(j)  (1280 + 64 * (j))
#define XB_XGEN(j)  (2304 + 64 * (j))
#define XB_TOP      3328
#define XB_TOPGEN   3392
#define XCD_BAR_WORDS 3456
#define XB_SPIN_CAP (1u << 18)

__device__ __forceinline__ unsigned xb_ld(unsigned* p)              { return __hip_atomic_load(p, __ATOMIC_RELAXED, __HIP_MEMORY_SCOPE_AGENT); }
__device__ __forceinline__ unsigned xb_add(unsigned* p, unsigned v) { return __hip_atomic_fetch_add(p, v, __ATOMIC_RELAXED, __HIP_MEMORY_SCOPE_AGENT); }
__device__ __forceinline__ unsigned xb_xcc_id() { return (unsigned)__builtin_amdgcn_s_getreg((3 << 11) | 20) & 0xFu; }
#define XB_SPIN(cond, bar) do { unsigned _sp = 0; while (cond) { __builtin_amdgcn_s_sleep(1); \
    if ((++_sp & 255u) == 0u) { if (xb_ld(&(bar)[XB_TMO])) break; if (_sp > XB_SPIN_CAP) { atomicAdd(&(bar)[XB_TMO], 1u); break; } } } } while (0)

struct XcdBarrier {
    unsigned* bar; unsigned x;
    volatile LAS unsigned* st;
};

__device__ __forceinline__ XcdBarrier xcd_barrier_post(unsigned* bar, volatile LAS unsigned* st) {
    XcdBarrier b; b.bar = bar; b.x = xb_xcc_id(); b.st = st;
    if (threadIdx.x == 0) (void)xb_add(&bar[XB_XCNT(b.x)], 1u);
    return b;
}
__device__ __forceinline__ void xcd_barrier_complete(unsigned* bar, unsigned x, unsigned& nloc, unsigned& nx) {
    const unsigned G = gridDim.x * gridDim.y * gridDim.z;
    unsigned sum, cnt, mine, sp = 0u;
    for (;;) {
        sum = 0u; cnt = 0u; mine = 0u;
#pragma unroll
        for (unsigned j = 0; j < 16; ++j) { const unsigned c = xb_ld(&bar[XB_XCNT(j)]); sum += c; cnt += (c > 0u) ? 1u : 0u; mine = (j == x) ? c : mine; }
        if (sum == G) break;
        __builtin_amdgcn_s_sleep(1);
        if ((++sp & 255u) == 0u) { if (xb_ld(&bar[XB_TMO])) break; if (sp > XB_SPIN_CAP) { atomicAdd(&bar[XB_TMO], 1u); break; } }
    }
    nloc = mine > 0u ? mine : 1u; nx = cnt > 0u ? cnt : 1u;
}

__device__ __forceinline__ void xcd_barrier(const XcdBarrier& b) {
    asm volatile("s_waitcnt vmcnt(0)" ::: "memory");
    __syncthreads();
    if (threadIdx.x == 0) {
        unsigned* bar = b.bar;
        __builtin_amdgcn_s_waitcnt(0);
        unsigned nloc = b.st[0], nx = b.st[1];
        if (nloc == 0u) { xcd_barrier_complete(bar, b.x, nloc, nx); b.st[0] = nloc; b.st[1] = nx; }
        const unsigned old = xb_add(&bar[XB_XSUB(b.x)], 1u);
        const unsigned gen = old / nloc;
        if (old + 1u == (gen + 1u) * nloc) {
            __builtin_amdgcn_fence(__ATOMIC_RELEASE, "agent");
            asm volatile("s_waitcnt vmcnt(0)" ::: "memory");
            const unsigned og = xb_add(&bar[XB_TOP], 1u);
            const unsigned tg = og / nx;
            if (og + 1u == (tg + 1u) * nx) xb_add(&bar[XB_TOPGEN], 1u);
            else XB_SPIN(xb_ld(&bar[XB_TOPGEN]) == tg, bar);
            __builtin_amdgcn_fence(__ATOMIC_ACQUIRE, "agent");
            xb_add(&bar[XB_XGEN(b.x)], 1u);
            asm volatile("s_waitcnt vmcnt(0)" ::: "memory");
        } else {
            XB_SPIN(xb_ld(&bar[XB_XGEN(b.x)]) == gen, bar);
            __builtin_amdgcn_fence(__ATOMIC_ACQUIRE, "agent");
            asm volatile("s_waitcnt vmcnt(0)" ::: "memory");
        }
    }
    __syncthreads();
}
constexpr int NWAVES = 8, NTHR = 512;
constexpr int DM = 1024, SEQ = 8192, MP = 16384, MS = 512, MT = MP + MS;
constexpr int NIN = 3584, DFF = 2816, NGU = 2 * DFF, HW = 512;
constexpr float RMS_EPS = 1e-6f, SUBLN_EPS = 1e-5f, ONE_MINUS_LAM_INIT = 0.8f, LAM_INIT = 0.2f;
constexpr float QSCALE = 0.125f * 1.4426950408889634f;
constexpr size_t OY = 0, OKP = 17301504, OVP = 25690112, OSP = 34078720, OKS = 34209792, OVS = 34471936, OSS = 34734080;
constexpr size_t MiB = 1u << 20;
constexpr size_t WS_CTL = 0, CTL_ZERO_BYTES = 1 * MiB;
constexpr size_t WS_SCAL = 1 * MiB, WS_ROPE = 2 * MiB;
constexpr size_t WS_WIN = 4 * MiB, WS_WOUT = 12 * MiB, WS_WGU = 14 * MiB, WS_WDN = 26 * MiB;
constexpr size_t WS_XN = 32 * MiB, WS_Q = 66 * MiB, WS_K = 84 * MiB, WS_V = 102 * MiB, WS_QH = 120 * MiB, WS_KH = 138 * MiB, WS_VH = 156 * MiB, WS_GH = 174 * MiB;
constexpr size_t WS_LF = 192 * MiB, WS_O16 = 226 * MiB, WS_HU = 260 * MiB, WS_HS = 292 * MiB, WS_HD = 324 * MiB, WS_OHS = 326 * MiB, WS_MIX = 328 * MiB;
constexpr size_t WS_X1 = 362 * MiB, WS_ACT = 430 * MiB, WS_END = 522 * MiB;
constexpr int CW_TMO = 0, CW_BAR = 4096;
constexpr int RING_OFF = 0, RING_BYTES = 131072, LDSCTL_OFF = RING_BYTES, MISC_OFF = LDSCTL_OFF + 320, LDS_BYTES = 147456;

typedef unsigned u32x2 __attribute__((ext_vector_type(2)));
__device__ __forceinline__ float wave_sum(float v) {
#pragma unroll
    for (int o = 1; o < 64; o <<= 1) v += __shfl_xor(v, o);
    return v;
}
__device__ __forceinline__ float bf2f(unsigned short b) { return __uint_as_float((unsigned)b << 16); }
__device__ __forceinline__ float sigmoidf_(float z) { return 1.f / (1.f + __expf(-z)); }
__device__ __forceinline__ f32x4 mfma16(bf16x8 a, bf16x8 b, f32x4 c) { return __builtin_amdgcn_mfma_f32_16x16x32_bf16(a, b, c, 0, 0, 0); }

struct Args { const float* in[21]; float* out; unsigned char* ws; };

__device__ __forceinline__ void p0_transpose_blk(const float* W, int K, int N, bf16* WT, int k0, int n0, int drow0, LAS float* scr, int lane) {
#pragma unroll 8
    for (int i = 0; i < 32; ++i) { const int kk = 2 * i + (lane >> 5); scr[kk * 33 + (lane & 31)] = W[(size_t)(k0 + kk) * N + n0 + (lane & 31)]; }
    LDS_WAIT(); asm volatile("" ::: "memory");
    const int c = lane & 7;
#pragma unroll
    for (int j = 0; j < 4; ++j) { const int n = (lane >> 3) + 8 * j; const LAS float* s = scr + (8 * c) * 33 + n;
        v4u o; o.x = pk2(s[0 * 33], s[1 * 33]); o.y = pk2(s[2 * 33], s[3 * 33]); o.z = pk2(s[4 * 33], s[5 * 33]); o.w = pk2(s[6 * 33], s[7 * 33]);
        *(GAS v4u*)(WT + (size_t)(drow0 + n) * K + k0 + 8 * c) = o; }
    LDS_WAIT(); asm volatile("" ::: "memory");
}
__device__ __forceinline__ void rms_row_to_bf16(const float* xrow, const float* gain, bf16* orow, int lane) {
    const GAS f32x4* xr = (const GAS f32x4*)xrow + lane; const GAS f32x4* gr = (const GAS f32x4*)gain + lane;
    f32x4 v[4]; float s = 0.f;
#pragma unroll
    for (int j = 0; j < 4; ++j) { v[j] = xr[64 * j]; s += (v[j].x * v[j].x + v[j].y * v[j].y) + (v[j].z * v[j].z + v[j].w * v[j].w); }
    const float rstd = 1.f / sqrtf(wave_sum(s) * (1.f / DM) + RMS_EPS);
    GAS unsigned long long* o8 = (GAS unsigned long long*)orow + lane;
#pragma unroll
    for (int j = 0; j < 4; ++j) { const f32x4 g = gr[64 * j];
        o8[64 * j] = (unsigned long long)pk2(v[j].x * rstd * g.x, v[j].y * rstd * g.y) | ((unsigned long long)pk2(v[j].z * rstd * g.z, v[j].w * rstd * g.w) << 32); }
}
__device__ __forceinline__ void p0_prologue(const Args& a, LAS unsigned char* lds, int vcu, int G, int tid, int lane, int wave) {
    unsigned char* ws = a.ws;
    LAS float* scr = (LAS float*)(lds + RING_OFF + wave * 16384);
    const int gw = vcu * NWAVES + wave, NGW = G * NWAVES;
    constexpr int I_IN = 16 * 112, I_OUT = 16 * 32, I_G = 16 * 88, I_DN = 44 * 32, NITEMS = I_IN + I_OUT + 2 * I_G + I_DN;
    for (int it = gw; it < NITEMS; it += NGW) {
        int r = it;
        if (r < I_IN) { const int kb = r / 112, nb = r % 112; p0_transpose_blk(a.in[7], DM, NIN, (bf16*)(ws + WS_WIN), 64 * kb, 32 * nb, 32 * nb, scr, lane); continue; } r -= I_IN;
        if (r < I_OUT) { const int kb = r / 32, nb = r % 32; p0_transpose_blk(a.in[8], DM, DM, (bf16*)(ws + WS_WOUT), 64 * kb, 32 * nb, 32 * nb, scr, lane); continue; } r -= I_OUT;
        if (r < I_G) { const int kb = r / 88, nb = r % 88, n0 = 32 * nb; p0_transpose_blk(a.in[17], DM, DFF, (bf16*)(ws + WS_WGU), 64 * kb, n0, (n0 >> 7) * 256 + (n0 & 127), scr, lane); continue; } r -= I_G;
        if (r < I_G) { const int kb = r / 88, nb = r % 88, n0 = 32 * nb; p0_transpose_blk(a.in[18], DM, DFF, (bf16*)(ws + WS_WGU), 64 * kb, n0, (n0 >> 7) * 256 + 128 + (n0 & 127), scr, lane); continue; } r -= I_G;
        { const int kb = r / 32, nb = r % 32; p0_transpose_blk(a.in[19], DFF, DM, (bf16*)(ws + WS_WDN), 64 * kb, 32 * nb, 32 * nb, scr, lane); }
    }
    for (int m = gw; m < MT; m += NGW) {
        const float* xrow = m < MP ? a.in[0] + (size_t)m * DM : a.in[1] + (size_t)(m - MP) * DM;
        rms_row_to_bf16(xrow, a.in[6], (bf16*)(ws + WS_XN) + (size_t)m * DM, lane);
    }
    for (int e = vcu * NTHR + tid; e < SEQ * 8; e += G * NTHR) {
        const int pos = e >> 3, j = e & 7;
        const float invf = j == 0 ? 1.0f : j == 1 ? 0.193922758102417f : j == 2 ? 0.03760603070259094f : j == 3 ? 0.00729266507551074f : j == 4 ? 0.001414213445968926f
                         : j == 5 ? 0.00027424818836152554f : j == 6 ? 5.318296462064609e-05f : 1.0313385246263351e-05f;
        const float ang = (float)pos * invf;
        const double rev = (double)ang * 0.15915494309189535; const float fr = (float)(rev - __builtin_rint(rev));
        ((float2*)(ws + WS_ROPE))[e] = make_float2(__builtin_amdgcn_cosf(fr), __builtin_amdgcn_sinf(fr));
    }
    if (vcu == 0) {
        float* scal = (float*)(ws + WS_SCAL);
        if (wave == 0) {
            const float s1 = wave_sum(a.in[9][lane] * a.in[10][lane]), s2 = wave_sum(a.in[11][lane] * a.in[12][lane]);
            if (lane == 0) scal[0] = __expf(s1) - __expf(s2) + LAM_INIT;
        }
        { const float l0 = a.in[14][tid], l1 = a.in[14][HW + tid]; scal[64 + tid] = 1.f / (1.f + __expf(l1 - l0)); }
    }
}

struct EpiInProj {
    static constexpr bool PERM = true, AFTER_DRAIN = false;
    bf16 *Q, *K, *V, *QH, *KH, *VH, *GH; float* LF; float* out; const float2* rope; const float* lb;
    __device__ __forceinline__ void operator()(const pg8::f32x4 (&acc)[2][2][4][2], const pg8::Unit& u, int wr, int wc, int fr, int fq) const {
        const int cls = u.pn >> 1, colt = (u.pn & 1) * 256;
        const int row0 = u.pm * 256 + wr * 64 + fr, col0 = colt + wc * 32 + 8 * fq;
#pragma unroll
        for (int ai = 0; ai < 2; ++ai)
#pragma unroll
            for (int m = 0; m < 4; ++m) {
                const int row = row0 + ai * 128 + m * 16;
#pragma unroll
                for (int bj = 0; bj < 2; ++bj) {
                    const int col = col0 + bj * 128;
                    float v[8];
#pragma unroll
                    for (int i = 0; i < 4; ++i) { v[i] = acc[ai][bj][m][0][i]; v[4 + i] = acc[ai][bj][m][1][i]; }
                    const size_t o512 = (size_t)row * HW + col;
                    if (cls <= 1) {
                        if ((wc & 1) == 0) {
                            float pv[8];
#pragma unroll
                            for (int i = 0; i < 8; ++i) pv[i] = __shfl_xor(v[i], 16);
                            if (fq < 2) {
                                const int pos = row < MP ? (row & (SEQ - 1)) : 2048 + ((row - MP) & 3);
                                const float2* cs = rope + pos * 8;
#pragma unroll
                                for (int i = 0; i < 8; ++i) { const float2 c = cs[i]; v[i] = fq == 0 ? v[i] * c.x - pv[i] * c.y : v[i] * c.x + pv[i] * c.y; }
                            }
                        }
                        if (cls == 0) {
                            v4u w; w.x = pk2(v[0] * QSCALE, v[1] * QSCALE); w.y = pk2(v[2] * QSCALE, v[3] * QSCALE); w.z = pk2(v[4] * QSCALE, v[5] * QSCALE); w.w = pk2(v[6] * QSCALE, v[7] * QSCALE);
                            *(v4u*)(Q + o512) = w;
                        } else {
                            v4u w; w.x = pk2(v[0], v[1]); w.y = pk2(v[2], v[3]); w.z = pk2(v[4], v[5]); w.w = pk2(v[6], v[7]);
                            *(v4u*)(K + o512) = w;
                            float* op = row < MP ? out + OKP + o512 : out + OKS + (size_t)(row - MP) * HW + col;
                            *(f32x4*)op = (f32x4){v[0], v[1], v[2], v[3]}; *(f32x4*)(op + 4) = (f32x4){v[4], v[5], v[6], v[7]};
                        }
                    } else if (cls == 2) {
                        v4u w; w.x = pk2(v[0], v[1]); w.y = pk2(v[2], v[3]); w.z = pk2(v[4], v[5]); w.w = pk2(v[6], v[7]);
                        *(v4u*)(V + o512) = w;
                        float* op = row < MP ? out + OVP + o512 : out + OVS + (size_t)(row - MP) * HW + col;
                        *(f32x4*)op = (f32x4){v[0], v[1], v[2], v[3]}; *(f32x4*)(op + 4) = (f32x4){v[4], v[5], v[6], v[7]};
                    } else if (cls == 3 || cls == 6) {
#pragma unroll
                        for (int i = 0; i < 8; ++i) v[i] = v[i] * sigmoidf_(v[i]);
                        v4u w; w.x = pk2(v[0], v[1]); w.y = pk2(v[2], v[3]); w.z = pk2(v[4], v[5]); w.w = pk2(v[6], v[7]);
                        *(v4u*)((cls == 3 ? QH : GH) + o512) = w;
                    } else if (cls == 4) {
                        const f32x4 l0 = *(const f32x4*)(lb + col), l1 = *(const f32x4*)(lb + col + 4);
                        float lg[8], kk[8];
#pragma unroll
                        for (int i = 0; i < 8; ++i) { const float lbv = i < 4 ? l0[i] : l1[i - 4]; const float f = lbv + (1.f - lbv) * sigmoidf_(v[i]); lg[i] = __logf(f); kk[i] = 1.f - f; }
                        *(f32x4*)(LF + o512) = (f32x4){lg[0], lg[1], lg[2], lg[3]}; *(f32x4*)(LF + o512 + 4) = (f32x4){lg[4], lg[5], lg[6], lg[7]};
                        v4u w; w.x = pk2(kk[0], kk[1]); w.y = pk2(kk[2], kk[3]); w.z = pk2(kk[4], kk[5]); w.w = pk2(kk[6], kk[7]);
                        *(v4u*)(KH + o512) = w;
                    } else {
                        v4u w; w.x = pk2(v[0], v[1]); w.y = pk2(v[2], v[3]); w.z = pk2(v[4], v[5]); w.w = pk2(v[6], v[7]);
                        *(v4u*)(VH + o512) = w;
                    }
                }
            }
    }
};
struct EpiResF32 {
    static constexpr bool PERM = false, AFTER_DRAIN = false;
    const float* basep; const float* bases; float* out;
    __device__ __forceinline__ void operator()(const pg8::f32x4 (&acc)[2][2][4][2], const pg8::Unit& u, int wr, int wc, int fr, int fq) const {
        const int col0 = u.pn * 256 + wc * 32 + 4 * fq;
#pragma unroll
        for (int ai = 0; ai < 2; ++ai)
#pragma unroll
            for (int m = 0; m < 4; ++m) {
                const int row = u.pm * 256 + ai * 128 + wr * 64 + m * 16 + fr;
                const float* bp = row < MP ? basep + (size_t)row * DM : bases + (size_t)(row - MP) * DM;
                float* op = out + (size_t)row * DM;
#pragma unroll
                for (int bj = 0; bj < 2; ++bj)
#pragma unroll
                    for (int n = 0; n < 2; ++n) { const int col = col0 + bj * 128 + n * 16; *(f32x4*)(op + col) = *(const f32x4*)(bp + col) + acc[ai][bj][m][n]; }
            }
    }
};
struct EpiSwiGLU {
    static constexpr bool PERM = true, AFTER_DRAIN = false;
    bf16* ACT;
    __device__ __forceinline__ void operator()(const pg8::f32x4 (&acc)[2][2][4][2], const pg8::Unit& u, int wr, int wc, int fr, int fq) const {
        const int col0 = u.pn * 128 + wc * 32 + 8 * fq;
#pragma unroll
        for (int ai = 0; ai < 2; ++ai)
#pragma unroll
            for (int m = 0; m < 4; ++m) {
                const int row = u.pm * 256 + ai * 128 + wr * 64 + m * 16 + fr;
                float v[8];
#pragma unroll
                for (int i = 0; i < 4; ++i) { const float g0 = acc[ai][0][m][0][i], g1 = acc[ai][0][m][1][i]; v[i] = g0 * sigmoidf_(g0) * acc[ai][1][m][0][i]; v[4 + i] = g1 * sigmoidf_(g1) * acc[ai][1][m][1][i]; }
                v4u w; w.x = pk2(v[0], v[1]); w.y = pk2(v[2], v[3]); w.z = pk2(v[4], v[5]); w.w = pk2(v[6], v[7]);
                *(v4u*)(ACT + (size_t)row * DFF + col0) = w;
            }
    }
};

__device__ __forceinline__ void hgrn_cumsum(const float* LF, int row0, int hcol, LAS float* tot, int tid, float (&b)[16], float& r31, float& blast) {
    const int k = tid & 127, tq = tid >> 7;
    const float* p = LF + (size_t)(row0 + 16 * tq) * HW + hcol + k;
    float c = 0.f;
#pragma unroll
    for (int i = 0; i < 16; ++i) { c += p[(size_t)i * HW]; b[i] = c; }
    tot[tq * 128 + k] = c;
    __syncthreads();
    const float t0 = tot[k], t1 = tot[128 + k], t2 = tot[256 + k], t3 = tot[384 + k];
    const float off = tq == 0 ? 0.f : tq == 1 ? t0 : tq == 2 ? t0 + t1 : (t0 + t1) + t2;
#pragma unroll
    for (int i = 0; i < 16; ++i) b[i] += off;
    r31 = t0 + t1; blast = (t0 + t1) + (t2 + t3);
}
constexpr int HL_TOT = 0, HL_VT = 2048, HL_KT = 20480, HL_QT = 20480, HL_QH = 37888, HL_KK = 55296, HL_AM = 72704, HL_SSQ = 81920;
__device__ __forceinline__ void hgrn_stage_vt(const bf16* VH, int row0, int hcol, LAS unsigned char* VT, int tid) {
    const int v = tid & 127, tq = tid >> 7;
    const bf16* vp = VH + (size_t)(row0 + 16 * tq) * HW + hcol + v;
    unsigned vw[8];
#pragma unroll
    for (int i = 0; i < 8; ++i) vw[i] = (unsigned)vp[(size_t)(2 * i) * HW] | ((unsigned)vp[(size_t)(2 * i + 1) * HW] << 16);
    *(LAS v4u*)(VT + v * 144 + tq * 32) = (v4u){vw[0], vw[1], vw[2], vw[3]};
    *(LAS v4u*)(VT + v * 144 + tq * 32 + 16) = (v4u){vw[4], vw[5], vw[6], vw[7]};
}
__device__ __forceinline__ void hgrn_a_item(int it, const float* LF, const bf16* KH, const bf16* VH, bf16* HU, float* HD, LAS unsigned char* lds, int tid, int lane, int wave) {
    const int bh = it >> 7, c = it & 127, b = bh >> 2, h = bh & 3, row0 = b * SEQ + c * 64, hcol = h * 128;
    LAS float* tot = (LAS float*)(lds + HL_TOT); LAS unsigned char* KT = lds + HL_KT; LAS unsigned char* VT = lds + HL_VT;
    float bb[16], r31, blast;
    hgrn_cumsum(LF, row0, hcol, tot, tid, bb, r31, blast);
    const int k = tid & 127, tq = tid >> 7;
    const bf16* kp = KH + (size_t)(row0 + 16 * tq) * HW + hcol + k;
    unsigned kw[8];
#pragma unroll
    for (int i = 0; i < 8; ++i) { const float k0 = bf2f(kp[(size_t)(2 * i) * HW]) * __expf(blast - bb[2 * i]), k1 = bf2f(kp[(size_t)(2 * i + 1) * HW]) * __expf(blast - bb[2 * i + 1]); kw[i] = pk2(k0, k1); }
    *(LAS v4u*)(KT + k * 144 + tq * 32) = (v4u){kw[0], kw[1], kw[2], kw[3]};
    *(LAS v4u*)(KT + k * 144 + tq * 32 + 16) = (v4u){kw[4], kw[5], kw[6], kw[7]};
    hgrn_stage_vt(VH, row0, hcol, VT, tid);
    if (tq == 0) HD[(size_t)(bh * 128 + c) * 128 + k] = __expf(blast);
    __syncthreads();
    const int l15 = lane & 15, quad = lane >> 4;
    const bf16x8 a0 = *(const LAS bf16x8*)(KT + (16 * wave + l15) * 144 + quad * 16), a1 = *(const LAS bf16x8*)(KT + (16 * wave + l15) * 144 + 64 + quad * 16);
#pragma unroll
    for (int nb = 0; nb < 8; ++nb) {
        const bf16x8 b0 = *(const LAS bf16x8*)(VT + (16 * nb + l15) * 144 + quad * 16), b1 = *(const LAS bf16x8*)(VT + (16 * nb + l15) * 144 + 64 + quad * 16);
        f32x4 acc = (f32x4){0.f, 0.f, 0.f, 0.f};
        acc = mfma16(a0, b0, acc); acc = mfma16(a1, b1, acc);
        *(u32x2*)(HU + ((size_t)(bh * 128 + c) * 128 + 16 * nb + l15) * 128 + 16 * wave + 4 * quad) = (u32x2){pk2(acc[0], acc[1]), pk2(acc[2], acc[3])};
    }
    __syncthreads();
}
__device__ __forceinline__ void hgrn_b_scan(const bf16* HU, const float* HD, bf16* HS, float* sout, int vcu, int G, int tid) {
    for (int e = vcu * NTHR + tid; e < 8 * 16384; e += G * NTHR) {
        const int bh = e >> 14, v = (e >> 7) & 127, k = e & 127;
        const size_t base = (size_t)bh * 128 * 16384 + (size_t)v * 128 + k;
        const float* dp = HD + (size_t)bh * 128 * 128 + k;
        float S = 0.f;
#pragma unroll 8
        for (int c = 0; c < 128; ++c) {
            const float u = bf2f(HU[base + (size_t)c * 16384]), d = dp[c * 128];
            HS[base + (size_t)c * 16384] = (bf16)f2bf(S);
            S = d * S + u;
        }
        sout[((size_t)bh * 128 + k) * 128 + v] = S;
    }
}
__device__ __forceinline__ void hgrn_c_item(int it, const float* LF, const bf16* QH, const bf16* KH, const bf16* VH, const bf16* GH, const bf16* HS, const float* hnorm, bf16* MIX,
                                            LAS unsigned char* lds, int tid, int lane, int wave) {
    const int b = it >> 7, c = it & 127, row0 = b * SEQ + c * 64;
    LAS float* tot = (LAS float*)(lds + HL_TOT); LAS unsigned char* VT = lds + HL_VT; LAS unsigned char* QT = lds + HL_QT; LAS unsigned char* QHt = lds + HL_QH;
    LAS unsigned char* KK = lds + HL_KK; LAS unsigned char* AM = lds + HL_AM; LAS float* SSQ = (LAS float*)(lds + HL_SSQ);
    const int l15 = lane & 15, quad = lane >> 4;
    f32x4 oacc[4][4];
#pragma unroll
    for (int h = 0; h < 4; ++h) {
        const int bh = b * 4 + h, hcol = h * 128;
        float bb[16], r31, blast;
        hgrn_cumsum(LF, row0, hcol, tot, tid, bb, r31, blast);
        const int k = tid & 127, tq = tid >> 7;
        const bf16* qp = QH + (size_t)(row0 + 16 * tq) * HW + hcol + k; const bf16* kp = KH + (size_t)(row0 + 16 * tq) * HW + hcol + k;
#pragma unroll
        for (int i = 0; i < 16; ++i) {
            const int t = 16 * tq + i; const float q = bf2f(qp[(size_t)i * HW]), kk = bf2f(kp[(size_t)i * HW]);
            *(LAS bf16*)(QT + t * 272 + k * 2) = (bf16)f2bf(q * __expf(bb[i] - r31));
            *(LAS bf16*)(QHt + t * 272 + k * 2) = (bf16)f2bf(q * __expf(bb[i]));
            *(LAS bf16*)(KK + t * 272 + k * 2) = (bf16)f2bf(kk * __expf(r31 - bb[i]));
        }
        hgrn_stage_vt(VH, row0, hcol, VT, tid);
        __syncthreads();
        {
            const int tb = wave >> 1;
#pragma unroll
            for (int e = 0; e < 2; ++e) {
                const int sb = 2 * (wave & 1) + e;
                f32x4 acc = (f32x4){0.f, 0.f, 0.f, 0.f};
                if (sb <= tb) {
#pragma unroll
                    for (int ks = 0; ks < 4; ++ks) {
                        const bf16x8 af = *(const LAS bf16x8*)(KK + (16 * sb + l15) * 272 + ks * 64 + quad * 16);
                        const bf16x8 bq = *(const LAS bf16x8*)(QT + (16 * tb + l15) * 272 + ks * 64 + quad * 16);
                        acc = mfma16(af, bq, acc);
                    }
                    const int t = 16 * tb + l15, s0 = 16 * sb + 4 * quad;
#pragma unroll
                    for (int j = 0; j < 4; ++j) if (s0 + j > t) acc[j] = 0.f;
                }
                *(LAS u32x2*)(AM + (16 * tb + l15) * 144 + (16 * sb + 4 * quad) * 2) = (u32x2){pk2(acc[0], acc[1]), pk2(acc[2], acc[3])};
            }
        }
        __syncthreads();
        {
            bf16x8 av[2], as[4];
#pragma unroll
            for (int ks = 0; ks < 2; ++ks) av[ks] = *(const LAS bf16x8*)(VT + (16 * wave + l15) * 144 + ks * 64 + quad * 16);
            const bf16* sp = HS + ((size_t)(bh * 128 + c) * 128 + 16 * wave + l15) * 128 + 8 * quad;
#pragma unroll
            for (int ks = 0; ks < 4; ++ks) as[ks] = *(const bf16x8*)(sp + 32 * ks);
#pragma unroll
            for (int tb = 0; tb < 4; ++tb) {
                f32x4 acc = (f32x4){0.f, 0.f, 0.f, 0.f};
#pragma unroll
                for (int ks = 0; ks < 2; ++ks) acc = mfma16(av[ks], *(const LAS bf16x8*)(AM + (16 * tb + l15) * 144 + ks * 64 + quad * 16), acc);
#pragma unroll
                for (int ks = 0; ks < 4; ++ks) acc = mfma16(as[ks], *(const LAS bf16x8*)(QHt + (16 * tb + l15) * 272 + ks * 64 + quad * 16), acc);
                oacc[h][tb] = acc;
            }
        }
        __syncthreads();
    }
#pragma unroll
    for (int tb = 0; tb < 4; ++tb) {
        float s = 0.f;
#pragma unroll
        for (int h = 0; h < 4; ++h)
#pragma unroll
            for (int j = 0; j < 4; ++j) s += oacc[h][tb][j] * oacc[h][tb][j];
        s += __shfl_xor(s, 16); s += __shfl_xor(s, 32);
        if (quad == 0) SSQ[wave * 64 + 16 * tb + l15] = s;
    }
    __syncthreads();
#pragma unroll
    for (int tb = 0; tb < 4; ++tb) {
        const int t = 16 * tb + l15; float ss = 0.f;
#pragma unroll
        for (int w = 0; w < 8; ++w) ss += SSQ[w * 64 + t];
        const float rstd = 1.f / sqrtf(ss * (1.f / HW) + RMS_EPS);
        const size_t row = (size_t)(row0 + t);
#pragma unroll
        for (int h = 0; h < 4; ++h) {
            const int col = h * 128 + 16 * wave + 4 * quad;
            const u32x2 g = *(const u32x2*)(GH + row * HW + col); const f32x4 wn = *(const f32x4*)(hnorm + col);
            const float v0 = oacc[h][tb][0] * rstd * wn[0] * __uint_as_float(g.x << 16), v1 = oacc[h][tb][1] * rstd * wn[1] * __uint_as_float(g.x & 0xffff0000u);
            const float v2 = oacc[h][tb][2] * rstd * wn[2] * __uint_as_float(g.y << 16), v3 = oacc[h][tb][3] * rstd * wn[3] * __uint_as_float(g.y & 0xffff0000u);
            *(u32x2*)(MIX + row * DM + HW + col) = (u32x2){pk2(v0, v1), pk2(v2, v3)};
        }
    }
    __syncthreads();
}
__device__ __forceinline__ void hgrn_dec_item(int it, const float* LF, const bf16* QH, const bf16* KH, const bf16* VH, const float* state, float* sout, float* OHS, LAS unsigned char* lds, int tid) {
    const int bd = it >> 2, h = it & 3, row0 = MP + bd * 4, hcol = h * 128;
    LAS float* F = (LAS float*)lds; LAS float* KKs = F + 512; LAS float* QQ = F + 1024; LAS float* OP = F + 1536;
    { const int t = tid >> 7, k = tid & 127; const size_t o = (size_t)(row0 + t) * HW + hcol + k; F[tid] = __expf(LF[o]); KKs[tid] = bf2f(KH[o]); QQ[tid] = bf2f(QH[o]); }
    __syncthreads();
    const int v = tid & 127, kg = tid >> 7;
    const size_t sbase = ((size_t)(bd * 4 + h) * 128 + 32 * kg) * 128 + v;
    float S[32];
#pragma unroll
    for (int i = 0; i < 32; ++i) S[i] = state[sbase + (size_t)i * 128];
#pragma unroll
    for (int t = 0; t < 4; ++t) {
        const float vv = bf2f(VH[(size_t)(row0 + t) * HW + hcol + v]); float op = 0.f;
#pragma unroll
        for (int i = 0; i < 32; ++i) { const int ki = t * 128 + 32 * kg + i; S[i] = F[ki] * S[i] + KKs[ki] * vv; op += S[i] * QQ[ki]; }
        OP[(kg * 4 + t) * 128 + v] = op;
    }
#pragma unroll
    for (int i = 0; i < 32; ++i) sout[sbase + (size_t)i * 128] = S[i];
    __syncthreads();
    { const int t = tid >> 7, vv = tid & 127; OHS[(size_t)(bd * 4 + t) * HW + hcol + vv] = (OP[(0 * 4 + t) * 128 + vv] + OP[(1 * 4 + t) * 128 + vv]) + (OP[(2 * 4 + t) * 128 + vv] + OP[(3 * 4 + t) * 128 + vv]); }
    __syncthreads();
}

__device__ __forceinline__ void mix_attn_row(const bf16* O16, float lam, const float* subw, bf16* MIX, size_t row, int lane) {
    const float w0 = subw[2 * lane] * ONE_MINUS_LAM_INIT, w1 = subw[2 * lane + 1] * ONE_MINUS_LAM_INIT;
#pragma unroll
    for (int h = 0; h < 4; ++h) {
        const unsigned a = *(const unsigned*)(O16 + row * DM + h * 256 + 2 * lane), b = *(const unsigned*)(O16 + row * DM + h * 256 + 128 + 2 * lane);
        const float d0 = __uint_as_float(a << 16) - lam * __uint_as_float(b << 16), d1 = __uint_as_float(a & 0xffff0000u) - lam * __uint_as_float(b & 0xffff0000u);
        const float rstd = 1.f / sqrtf(wave_sum(d0 * d0 + d1 * d1) * (1.f / 128.f) + SUBLN_EPS);
        *(unsigned*)(MIX + row * DM + h * 128 + 2 * lane) = pk2(d0 * rstd * w0, d1 * rstd * w1);
    }
}
__device__ __forceinline__ void mix_hgrn_row(const float* OHS, const bf16* GH, const float* hnorm, bf16* MIX, int srow, int lane) {
    const f32x4 x0 = *(const f32x4*)(OHS + (size_t)srow * HW + 4 * lane), x1 = *(const f32x4*)(OHS + (size_t)srow * HW + 256 + 4 * lane);
    const float ss = wave_sum((x0.x * x0.x + x0.y * x0.y) + (x0.z * x0.z + x0.w * x0.w) + (x1.x * x1.x + x1.y * x1.y) + (x1.z * x1.z + x1.w * x1.w));
    const float rstd = 1.f / sqrtf(ss * (1.f / HW) + RMS_EPS);
    const size_t row = (size_t)(MP + srow);
#pragma unroll
    for (int p = 0; p < 2; ++p) {
        const f32x4 x = p == 0 ? x0 : x1; const int col = 256 * p + 4 * lane;
        const u32x2 g = *(const u32x2*)(GH + row * HW + col); const f32x4 wn = *(const f32x4*)(hnorm + col);
        const float v0 = x.x * rstd * wn[0] * __uint_as_float(g.x << 16), v1 = x.y * rstd * wn[1] * __uint_as_float(g.x & 0xffff0000u);
        const float v2 = x.z * rstd * wn[2] * __uint_as_float(g.y << 16), v3 = x.w * rstd * wn[3] * __uint_as_float(g.y & 0xffff0000u);
        *(u32x2*)(MIX + row * DM + HW + col) = (u32x2){pk2(v0, v1), pk2(v2, v3)};
    }
}
__device__ __forceinline__ void rms_row_inplace(float* xrow, const float* gain, int lane) {
    GAS f32x4* xr = (GAS f32x4*)xrow + lane; const GAS f32x4* gr = (const GAS f32x4*)gain + lane;
    f32x4 v[4]; float s = 0.f;
#pragma unroll
    for (int j = 0; j < 4; ++j) { v[j] = xr[64 * j]; s += (v[j].x * v[j].x + v[j].y * v[j].y) + (v[j].z * v[j].z + v[j].w * v[j].w); }
    const float rstd = 1.f / sqrtf(wave_sum(s) * (1.f / DM) + RMS_EPS);
#pragma unroll
    for (int j = 0; j < 4; ++j) { const f32x4 g = gr[64 * j]; xr[64 * j] = (f32x4){v[j].x * rstd * g.x, v[j].y * rstd * g.y, v[j].z * rstd * g.z, v[j].w * rstd * g.w}; }
}
namespace dec {
using bf16x2v = __attribute__((ext_vector_type(2))) __bf16;
using f32x8 = __attribute__((ext_vector_type(8))) float;
using u32x4 = __attribute__((ext_vector_type(4))) unsigned;
using f32x2 = __attribute__((ext_vector_type(2))) float;
constexpr int WAVES = 8, GEP = 8, HPL = 2, PPW = 16, TOKS = 512;
constexpr int LDS_P = 0, LDS_AL = WAVES * 128, LDS_MRG = LDS_AL + 64, MRG_REC = 4 + 128, LDS_OUT = LDS_MRG + WAVES * GEP * MRG_REC, LDS_FLOATS = LDS_OUT + 8 * 128;
__device__ __forceinline__ float dot2(unsigned k, unsigned q, float acc) { return __builtin_amdgcn_fdot2_f32_bf16(__builtin_bit_cast(bf16x2v, k), __builtin_bit_cast(bf16x2v, q), acc, false); }
__device__ __forceinline__ unsigned cvtpk(float lo, float hi) { unsigned r; asm volatile("v_cvt_pk_bf16_f32 %0, %1, %2" : "=v"(r) : "v"(lo), "v"(hi)); return r; }
template <int CTRL> __device__ __forceinline__ float dpp(float x) { return __builtin_bit_cast(float, __builtin_amdgcn_mov_dpp(__builtin_bit_cast(int, x), CTRL, 0xf, 0xf, true)); }
constexpr int XOR1 = 0xB1, XOR2 = 0x4E, XOR7 = 0x141, XOR8 = 0x128, ROR4 = 0x124;
__device__ __forceinline__ float xrow16_max(float x) {
    auto s = __builtin_amdgcn_permlane16_swap(__float_as_uint(x), __float_as_uint(x), false, false);
    x = fmaxf(__uint_as_float(s[0]), __uint_as_float(s[1]));
    auto t = __builtin_amdgcn_permlane32_swap(__float_as_uint(x), __float_as_uint(x), false, false);
    return fmaxf(__uint_as_float(t[0]), __uint_as_float(t[1]));
}
__device__ __forceinline__ float xrow16_sum(float x) {
    auto s = __builtin_amdgcn_permlane16_swap(__float_as_uint(x), __float_as_uint(x), false, false);
    x = __uint_as_float(s[0]) + __uint_as_float(s[1]);
    auto t = __builtin_amdgcn_permlane32_swap(__float_as_uint(x), __float_as_uint(x), false, false);
    return __uint_as_float(t[0]) + __uint_as_float(t[1]);
}
__device__ __forceinline__ u32x4 tobf(f32x8 x) { u32x4 w = {cvtpk(x[0], x[1]), cvtpk(x[2], x[3]), cvtpk(x[4], x[5]), cvtpk(x[6], x[7])}; return w; }
__device__ __forceinline__ f32x8 ld8nt(const float* p) { return __builtin_nontemporal_load(reinterpret_cast<const f32x8*>(p)); }

__device__ __forceinline__ void decode_attn_item(int it, const unsigned short* Qb, const unsigned short* Kb, const unsigned short* Vb, const float* ck, const float* cv, const int* pt,
                                                 float lam, const float* subw, unsigned short* MIX, LAS float* lds) {
    const int tid = opaque_tid(), lane = tid & 63, wave = __builtin_amdgcn_readfirstlane(tid >> 6); (void)tid;
    const int bd = it >> 2, h = it & 3, r = lane >> 4, c = lane & 15;
    const size_t qrow0 = (size_t)(MP + bd * 4);
    int btv = 0; if (lane < 16) btv = pt[bd * 16 + lane];
    bf16x8 qf[4];
#pragma unroll
    for (int ks = 0; ks < 4; ++ks) {
        const u32x4 w = (c < 8 && (c >> 2) == (ks >> 1)) ? *reinterpret_cast<const u32x4*>(Qb + (qrow0 + (c & 3)) * 512 + h * 128 + 32 * ks + 8 * r) : u32x4{0u, 0u, 0u, 0u};
        qf[ks] = __builtin_bit_cast(bf16x8, w);
    }
    const size_t koff = (size_t)(wave * 16 + c) * TOKS + h * 128 + 8 * r;
    const size_t voff = (size_t)(wave * 16 + r) * TOKS + h * 128 + 8 * c;
#define DEC_ISSUE_K(i_) do { const int phys_ = __builtin_amdgcn_readlane(btv, (i_)); const float* kb_ = ck + (size_t)phys_ * (128 * TOKS) + koff; \
    _Pragma("unroll") for (int t_ = 0; t_ < 4; ++t_) Kn[t_] = ld8nt(kb_ + 32 * t_); } while (0)
#define DEC_ISSUE_V(i_) do { const int phys_ = __builtin_amdgcn_readlane(btv, (i_)); const float* vb_ = cv + (size_t)phys_ * (128 * TOKS) + voff; \
    _Pragma("unroll") for (int t_ = 0; t_ < 4; ++t_) Vn[t_] = ld8nt(vb_ + (size_t)t_ * 4 * TOKS); } while (0)
    f32x8 Kn[4], Vn[4];
    float m = -INFINITY, l = 0.f;
    f32x2 acc[GEP * 4];
#pragma unroll
    for (int k = 0; k < GEP * 4; ++k) acc[k] = (f32x2){0.f, 0.f};
    LAS float* prow = lds + LDS_P + wave * 128;
    LAS float* arow = lds + LDS_AL + wave * 8;
    DEC_ISSUE_K(0); DEC_ISSUE_V(0);
    for (int i = 0; i < PPW; ++i) {
        f32x4 sc = (f32x4){0.f, 0.f, 0.f, 0.f};
        {
            bf16x8 Kc[4];
#pragma unroll
            for (int ks = 0; ks < 4; ++ks) Kc[ks] = __builtin_bit_cast(bf16x8, tobf(Kn[ks]));
            if (i + 1 < PPW) DEC_ISSUE_K(i + 1);
#pragma unroll
            for (int ks = 0; ks < 4; ++ks) sc = __builtin_amdgcn_mfma_f32_16x16x32_bf16(Kc[ks], qf[ks], sc, 0, 0, 0);
        }
        float pm = fmaxf(fmaxf(sc[0], sc[1]), fmaxf(sc[2], sc[3])); pm = xrow16_max(pm);
        const float mn = fmaxf(m, pm), alpha = __builtin_amdgcn_exp2f(m - mn);
        const float p0 = __builtin_amdgcn_exp2f(sc[0] - mn), p1 = __builtin_amdgcn_exp2f(sc[1] - mn), p2 = __builtin_amdgcn_exp2f(sc[2] - mn), p3 = __builtin_amdgcn_exp2f(sc[3] - mn);
        l = fmaf(l, alpha, (p0 + p1) + (p2 + p3)); m = mn;
        const bool resc = __any(alpha != 1.f);
        if (c < 8) {
            prow[0 * 32 + r * 8 + c] = p0; prow[1 * 32 + r * 8 + c] = p1; prow[2 * 32 + r * 8 + c] = p2; prow[3 * 32 + r * 8 + c] = p3;
            if (r == 0) arow[c] = alpha;
        }
        asm volatile("s_waitcnt lgkmcnt(0)" ::: "memory");
        if (resc) {
            const f32x4 a0 = *(const LAS f32x4*)(arow), a1 = *(const LAS f32x4*)(arow + 4);
#pragma unroll
            for (int g = 0; g < GEP; ++g) { const float al = g < 4 ? a0[g] : a1[g - 4];
#pragma unroll
                for (int k = 0; k < 4; ++k) acc[g * 4 + k] *= al; }
        }
        u32x4 Vc[4];
#pragma unroll
        for (int t = 0; t < 4; ++t) Vc[t] = tobf(Vn[t]);
        if (i + 1 < PPW) DEC_ISSUE_V(i + 1);
        f32x4 pr[GEP];
#pragma unroll
        for (int u = 0; u < GEP; ++u) pr[u] = *(const LAS f32x4*)(prow + r * 32 + 4 * u);
#pragma unroll
        for (int t = 0; t < 4; ++t) {
            f32x2 vf[4];
#pragma unroll
            for (int k = 0; k < 4; ++k) vf[k] = (f32x2){__builtin_bit_cast(float, Vc[t][k] << 16), __builtin_bit_cast(float, Vc[t][k] & 0xffff0000u)};
#pragma unroll
            for (int g = 0; g < GEP; ++g) { const float pg_ = pr[(t * GEP + g) >> 2][(t * GEP + g) & 3]; const f32x2 pp = (f32x2){pg_, pg_};
#pragma unroll
                for (int k = 0; k < 4; ++k) acc[g * 4 + k] = __builtin_elementwise_fma(pp, vf[k], acc[g * 4 + k]); } }
        asm volatile("s_waitcnt lgkmcnt(0)" ::: "memory");
    }
#undef DEC_ISSUE_K
#undef DEC_ISSUE_V
#pragma unroll
    for (int k = 0; k < GEP * 4; ++k) { acc[k].x = xrow16_sum(acc[k].x); acc[k].y = xrow16_sum(acc[k].y); }
    l = xrow16_sum(l);
    LAS float* mrg = lds + LDS_MRG;
    if (r == 0) {
#pragma unroll
        for (int g = 0; g < GEP; ++g) {
            LAS float* rec = mrg + (wave * GEP + g) * MRG_REC;
            *(LAS f32x4*)(rec + 4 + 8 * c) = f32x4{acc[g * 4].x, acc[g * 4].y, acc[g * 4 + 1].x, acc[g * 4 + 1].y};
            *(LAS f32x4*)(rec + 4 + 8 * c + 4) = f32x4{acc[g * 4 + 2].x, acc[g * 4 + 2].y, acc[g * 4 + 3].x, acc[g * 4 + 3].y};
        }
        if (c < 8) { LAS float* rec = mrg + (wave * GEP + c) * MRG_REC; rec[0] = m; rec[1] = l; }
    }
    __syncthreads();
    {
        const int g = wave, map = g >> 2, qi = g & 3, d0 = 2 * lane;
        const float qv = bf2f(Qb[(qrow0 + qi) * 512 + h * 128 + map * 64 + lane]);
        float sn[4];
#pragma unroll
        for (int j = 0; j < 4; ++j) sn[j] = wave_sum(qv * bf2f(Kb[(qrow0 + j) * 512 + h * 128 + map * 64 + lane]));
        float M = -INFINITY;
#pragma unroll
        for (int w = 0; w < WAVES; ++w) M = fmaxf(M, mrg[(w * GEP + g) * MRG_REC]);
#pragma unroll
        for (int j = 0; j < 4; ++j) if (j <= qi) M = fmaxf(M, sn[j]);
        float L = 0.f, o0 = 0.f, o1 = 0.f;
#pragma unroll
        for (int w = 0; w < WAVES; ++w) { const LAS float* rec = mrg + (w * GEP + g) * MRG_REC; const float lw = rec[1];
            const float wt = __builtin_amdgcn_exp2f(rec[0] - M);
            L = fmaf(wt, lw, L); o0 = fmaf(wt, rec[4 + d0], o0); o1 = fmaf(wt, rec[4 + d0 + 1], o1); }
#pragma unroll
        for (int j = 0; j < 4; ++j) if (j <= qi) {
            const float pj = __builtin_amdgcn_exp2f(sn[j] - M);
            const unsigned vw = *reinterpret_cast<const unsigned*>(Vb + (qrow0 + j) * 512 + h * 128 + d0);
            L += pj; o0 = fmaf(pj, __uint_as_float(vw << 16), o0); o1 = fmaf(pj, __uint_as_float(vw & 0xffff0000u), o1); }
        const float inv = 1.f / L;
        lds[LDS_OUT + g * 128 + d0] = o0 * inv; lds[LDS_OUT + g * 128 + d0 + 1] = o1 * inv;
    }
    __syncthreads();
    if (wave < 4) {
        const int qi = wave, d0 = 2 * lane;
        const float a0 = lds[LDS_OUT + qi * 128 + d0] - lam * lds[LDS_OUT + (4 + qi) * 128 + d0], a1 = lds[LDS_OUT + qi * 128 + d0 + 1] - lam * lds[LDS_OUT + (4 + qi) * 128 + d0 + 1];
        const float rstd = 1.f / sqrtf(wave_sum(a0 * a0 + a1 * a1) * (1.f / 128.f) + SUBLN_EPS);
        *reinterpret_cast<unsigned*>(MIX + (qrow0 + qi) * DM + h * 128 + d0) = pk2(a0 * rstd * subw[d0] * ONE_MINUS_LAM_INIT, a1 * rstd * subw[d0 + 1] * ONE_MINUS_LAM_INIT);
    }
    __syncthreads();
}
}
#ifndef PH
#define PH 0xFFFF
#endif
#ifndef DBL
#define DBL 0
#endif
#define REP(bit) for (int rep_ = 0; rep_ < ((DBL & (bit)) ? 2 : 1); ++rep_)
struct AttnOrder {
    int vcu, G;
    __device__ __forceinline__ bool next(int i, attn_body::AttnUnit& u) const {
        const int slot = vcu + (i >> 2) * G; if (slot >= 256) return false;
        const int s = slot & 7, k = i & 3; u.bh = slot >> 3; u.qb = (k == 0) ? s : (k == 1) ? 15 - s : (k == 2) ? 16 + s : 31 - s; return true; }
    __device__ __forceinline__ void a_ready(const attn_body::AttnUnit&) const {}
    __device__ __forceinline__ void done(const attn_body::AttnUnit&) const {}
};

__device__ __forceinline__ const unsigned long long* karg() {
    const unsigned long long __attribute__((address_space(4)))* p = (const unsigned long long __attribute__((address_space(4)))*)__builtin_amdgcn_kernarg_segment_ptr();
    asm volatile("" : "+s"(p)); return (const unsigned long long*)p; }
#define ARG_IN(i) ((const float*)(const GAS float*)karg()[(i)])
#define ARG_OUT ((float*)(GAS float*)karg()[21])
#define ARG_WS ((unsigned char*)(GAS unsigned char*)karg()[22])

__global__ void __launch_bounds__(NTHR, 2) hybrid_fwd(Args args) {
    extern __shared__ __attribute__((aligned(16))) unsigned char lds_raw[];
    LAS unsigned char* lds = (LAS unsigned char*)lds_raw;
    volatile LAS unsigned* MISC = (volatile LAS unsigned*)(lds + MISC_OFF);
    const int G = gridDim.x, bx = blockIdx.x, vcu = (G % 8 == 0) ? (bx % 8) * (G / 8) + bx / 8 : bx;
    const int NGW = G * NWAVES;
#define PHASE_IDS() const int tid = opaque_tid(), lane = tid & 63, wave = __builtin_amdgcn_readfirstlane(tid >> 6), gw = vcu * NWAVES + wave; (void)lane; (void)gw
    for (int u = threadIdx.x; u < (LDS_BYTES - LDSCTL_OFF) / 4; u += NTHR) ((LAS unsigned*)(lds + LDSCTL_OFF))[u] = 0u;
    __syncthreads();
    XcdBarrier bar = xcd_barrier_post((unsigned*)((gu32*)(args.ws + WS_CTL) + CW_BAR), MISC + 8);

    REP(1) if (PH & 1) { PHASE_IDS(); p0_prologue(args, lds, vcu, G, tid, lane, wave); }
    xcd_barrier(bar);

    REP(2) if (PH & 2) {
        unsigned char* ws = ARG_WS;
        pg8::Gemm g{(bf16*)(ws + WS_XN), (bf16*)(ws + WS_WIN), MT, NIN, DM}; pg8::StaticOrder S; S.init(MT, NIN, G, bx);
        EpiInProj E{(bf16*)(ws + WS_Q), (bf16*)(ws + WS_K), (bf16*)(ws + WS_V), (bf16*)(ws + WS_QH), (bf16*)(ws + WS_KH), (bf16*)(ws + WS_VH), (bf16*)(ws + WS_GH), (float*)(ws + WS_LF), ARG_OUT,
                    (const float2*)(ws + WS_ROPE), (const float*)(ws + WS_SCAL) + 64};
        pg8::gemm_phase<EpiInProj, pg8::StaticOrder, PG8_ALIGN, PG8_SP2>(lds + RING_OFF, g, S, E);
    }
    xcd_barrier(bar);

    REP(4) if (PH & 4) { PHASE_IDS(); unsigned char* ws = ARG_WS;
        for (int it = vcu; it < 1024; it += G) hgrn_a_item(it, (const float*)(ws + WS_LF), (const bf16*)(ws + WS_KH), (const bf16*)(ws + WS_VH), (bf16*)(ws + WS_HU), (float*)(ws + WS_HD), lds, tid, lane, wave); }
    REP(8) if (PH & 8) { PHASE_IDS(); unsigned char* ws = ARG_WS; const float* st = ARG_IN(4); float* out = ARG_OUT;
        for (int it = vcu; it < 512; it += G) hgrn_dec_item(it, (const float*)(ws + WS_LF), (const bf16*)(ws + WS_QH), (const bf16*)(ws + WS_KH), (const bf16*)(ws + WS_VH), st, out + OSS, (float*)(ws + WS_OHS), lds, tid); }
    xcd_barrier(bar);

    REP(16) if (PH & 16) { PHASE_IDS(); unsigned char* ws = ARG_WS; hgrn_b_scan((const bf16*)(ws + WS_HU), (const float*)(ws + WS_HD), (bf16*)(ws + WS_HS), ARG_OUT + OSP, vcu, G, tid); }
    REP(32) if (PH & 32) {
        unsigned char* ws = ARG_WS;
        const attn_body::bf16* Qa = (const attn_body::bf16*)(ws + WS_Q); const attn_body::bf16* Ka = (const attn_body::bf16*)(ws + WS_K); const attn_body::bf16* Va = (const attn_body::bf16*)(ws + WS_V);
        const float lam = ((const float*)(ws + WS_SCAL))[0];
        for (int slot = vcu; slot < 256; slot += G) {
            const int pos = slot & 3, s8 = slot & 7, bh = slot >> 3;
            for (int i = 0; i < 4; ++i) {
                if ((PH & 64) && i == pos) {
                    const float* ck = ARG_IN(2); const float* cv = ARG_IN(3); const int* pt = (const int*)ARG_IN(5); const float* subw = ARG_IN(13);
                    for (int rep2_ = 0; rep2_ < ((DBL & 64) ? 2 : 1); ++rep2_)
                    for (int it = slot; it < 512; it += 256)
                        dec::decode_attn_item(it, (const bf16*)(ws + WS_Q), (const bf16*)(ws + WS_K), (const bf16*)(ws + WS_V), ck, cv, pt, lam, subw, (bf16*)(ws + WS_MIX), (LAS float*)lds);
                }
                const int qb = (i == 0) ? s8 : (i == 1) ? 15 - s8 : (i == 2) ? 16 + s8 : 31 - s8;
                attn_body::attn_unit<8>(bh >> 4, bh & 15, qb, Qa, Ka, Va, (attn_body::bf16*)(ws + WS_O16), (char*)lds_raw + RING_OFF);
            }
        }
    }
    xcd_barrier(bar);

    REP(128) if (PH & 128) { PHASE_IDS(); unsigned char* ws = ARG_WS; const float* hn = ARG_IN(15);
        for (int it = vcu; it < 256; it += G) hgrn_c_item(it, (const float*)(ws + WS_LF), (const bf16*)(ws + WS_QH), (const bf16*)(ws + WS_KH), (const bf16*)(ws + WS_VH), (const bf16*)(ws + WS_GH),
                                                          (const bf16*)(ws + WS_HS), hn, (bf16*)(ws + WS_MIX), lds, tid, lane, wave); }
    REP(256) if (PH & 256) {
        PHASE_IDS(); unsigned char* ws = ARG_WS; const float* subw = ARG_IN(13); const float* hn = ARG_IN(15);
        const float lam = ((const float*)(ws + WS_SCAL))[0];
        for (int m = gw; m < MP; m += NGW) mix_attn_row((const bf16*)(ws + WS_O16), lam, subw, (bf16*)(ws + WS_MIX), (size_t)m, lane);
        for (int m = gw; m < MS; m += NGW) mix_hgrn_row((const float*)(ws + WS_OHS), (const bf16*)(ws + WS_GH), hn, (bf16*)(ws + WS_MIX), m, lane);
    }
    xcd_barrier(bar);

    REP(512) if (PH & 512) {
        unsigned char* ws = ARG_WS;
        pg8::Gemm g{(bf16*)(ws + WS_MIX), (bf16*)(ws + WS_WOUT), MT, DM, DM}; pg8::StaticOrder S; S.init(MT, DM, G, bx);
        EpiResF32 E{ARG_IN(0), ARG_IN(1), (float*)(ws + WS_X1)};
        pg8::gemm_phase<EpiResF32, pg8::StaticOrder, PG8_ALIGN, PG8_SP2>(lds + RING_OFF, g, S, E);
    }
    xcd_barrier(bar);

    REP(1024) if (PH & 1024) { PHASE_IDS(); unsigned char* ws = ARG_WS; const float* gn = ARG_IN(16);
        for (int m = gw; m < MT; m += NGW) rms_row_to_bf16((const float*)(ws + WS_X1) + (size_t)m * DM, gn, (bf16*)(ws + WS_XN) + (size_t)m * DM, lane); }
    xcd_barrier(bar);

    REP(2048) if (PH & 2048) {
        unsigned char* ws = ARG_WS;
        pg8::Gemm g{(bf16*)(ws + WS_XN), (bf16*)(ws + WS_WGU), MT, NGU, DM}; pg8::StaticOrder S; S.init(MT, NGU, G, bx);
        EpiSwiGLU E{(bf16*)(ws + WS_ACT)};
        pg8::gemm_phase<EpiSwiGLU, pg8::StaticOrder, PG8_ALIGN, PG8_SP2>(lds + RING_OFF, g, S, E);
    }
    xcd_barrier(bar);

    REP(4096) if (PH & 4096) {
        unsigned char* ws = ARG_WS;
        pg8::Gemm g{(bf16*)(ws + WS_ACT), (bf16*)(ws + WS_WDN), MT, DM, DFF}; pg8::StaticOrder S; S.init(MT, DM, G, bx);
        EpiResF32 E{(const float*)(ws + WS_X1), (const float*)(ws + WS_X1) + (size_t)MP * DM, ARG_OUT + OY};
        pg8::gemm_phase<EpiResF32, pg8::StaticOrder, PG8_ALIGN, PG8_SP2>(lds + RING_OFF, g, S, E);
    }
    xcd_barrier(bar);

    REP(8192) if (PH & 8192) { PHASE_IDS(); float* out = ARG_OUT; const float* gn = ARG_IN(20);
        for (int m = gw; m < MT; m += NGW) rms_row_inplace(out + OY + (size_t)m * DM, gn, lane); }
}

extern "C" void kernel_launch(void* const* d_in, const int* in_sizes, int n_in, void* d_out, int out_size, void* d_ws, size_t ws_size, hipStream_t stream) {
    static int grid = 0;
    if (grid == 0) {
        if (n_in != 21 || ws_size < WS_END) { fprintf(stderr, "kernel_launch: unexpected problem (n_in %d, ws %zu)\n", n_in, ws_size); grid = -1; return; }
        int dev = 0, cus = 0, per_cu = 0;
        if (hipGetDevice(&dev) != hipSuccess || hipDeviceGetAttribute(&cus, hipDeviceAttributeMultiprocessorCount, dev) != hipSuccess) { grid = -1; return; }
        if (hipFuncSetAttribute((const void*)hybrid_fwd, hipFuncAttributeMaxDynamicSharedMemorySize, LDS_BYTES) != hipSuccess) { fprintf(stderr, "kernel_launch: hipFuncSetAttribute failed\n"); grid = -1; return; }
        if (hipOccupancyMaxActiveBlocksPerMultiprocessor(&per_cu, (const void*)hybrid_fwd, NTHR, LDS_BYTES) != hipSuccess || per_cu < 1)
            fprintf(stderr, "kernel_launch: note: occupancy query reports %d workgroups per CU\n", per_cu);
        (void)hipGetLastError();
        grid = cus > 256 ? 256 : cus;
    }
    if (grid < 0) return;
    if (hipMemsetAsync((char*)d_ws + WS_CTL, 0, CTL_ZERO_BYTES, stream) != hipSuccess) { fprintf(stderr, "kernel_launch: memset failed\n"); return; }
    Args a{};
    for (int i = 0; i < 21; ++i) a.in[i] = (const float*)d_in[i];
    a.out = (float*)d_out; a.ws = (unsigned char*)d_ws;
    hipLaunchKernelGGL(hybrid_fwd, dim3(grid), dim3(NTHR), LDS_BYTES, stream, a);
    const hipError_t le = hipPeekAtLastError();
    if (le != hipSuccess) fprintf(stderr, "kernel_launch: launch failed: %s\n", hipGetErrorName(le));
}
```
